# Optimizing an MI355X kernel written in HIP

```python
import math
import jax, jax.numpy as jnp
from jax import lax
import numpy as np

D_MODEL = 2048
BATCH = 1
SEQ = 8192
DEPTH = 1

GRID_W = 64
CTX_LEN = 256
N_DIFF_HEADS = D_MODEL // 256
HEAD_DIM = 64
V_HEAD_DIM = 2 * HEAD_DIM
ATTN_WIDTH = N_DIFF_HEADS * V_HEAD_DIM
SGU_WIDTH = D_MODEL // 2
N_SGU_GROUPS = 8
SGU_GROUP_DIM = SGU_WIDTH // N_SGU_GROUPS
CHUNK = 128
Q_BLOCK = 128
FF_DIM = 4 * D_MODEL
IN_WIDTH = 3 * ATTN_WIDTH + 2 * SGU_WIDTH
ROPE_BASE = 10000.0
EPS = 1e-6

kernel_name = "hybrid_diffattn_sgu_dit_block"


def rms_norm(x, g):
    xf = x.astype(jnp.float32)
    y = xf * lax.rsqrt(jnp.mean(xf * xf, axis=-1, keepdims=True) + EPS)
    return (y * g.astype(jnp.float32)).astype(x.dtype)


def layer_norm(x, g, b):
    xf = x.astype(jnp.float32)
    mu = jnp.mean(xf, axis=-1, keepdims=True)
    var = jnp.mean(jnp.square(xf - mu), axis=-1, keepdims=True)
    y = (xf - mu) * lax.rsqrt(var + EPS)
    return (y * g.astype(jnp.float32) + b.astype(jnp.float32)).astype(x.dtype)


def modulated_norm(x, g, shift, scale):
    return rms_norm(x, g) * (1 + scale) + shift


def axial_rope_tables(n_tokens):
    rows = n_tokens // GRID_W
    r, col = jnp.meshgrid(jnp.arange(rows, dtype=jnp.float32),
                          jnp.arange(GRID_W, dtype=jnp.float32), indexing="ij")
    n_freq = HEAD_DIM // 4
    inv = ROPE_BASE ** (-jnp.arange(n_freq, dtype=jnp.float32) / n_freq)
    ang = jnp.concatenate([r.reshape(-1, 1) * inv, col.reshape(-1, 1) * inv], axis=-1)
    return jnp.cos(ang), jnp.sin(ang)


def apply_rope(t, cos, sin):
    tf = t.astype(jnp.float32).reshape(t.shape[:-1] + (HEAD_DIM // 2, 2))
    t1, t2 = tf[..., 0], tf[..., 1]
    cs, sn = cos[None, :, None, :], sin[None, :, None, :]
    out = jnp.stack([t1 * cs - t2 * sn, t1 * sn + t2 * cs], axis=-1)
    return out.reshape(t.shape).astype(t.dtype)


def diff_attention(q, k, v, lam, lam_init, subln_g):
    B, Nq = q.shape[0], q.shape[1]
    Nk = k.shape[1]
    nb = Nq // Q_BLOCK
    scale = HEAD_DIM ** -0.5
    qb = q.reshape(B, nb, Q_BLOCK, 2 * N_DIFF_HEADS, HEAD_DIM).transpose(1, 0, 2, 3, 4)

    def one_block(qblk):
        s = jnp.einsum("bqhd,bkhd->bhqk", qblk, k).astype(jnp.float32) * scale
        p = jax.nn.softmax(s, axis=-1).reshape(B, N_DIFF_HEADS, 2, Q_BLOCK, Nk)
        a = p[:, :, 0] - lam * p[:, :, 1]
        return jnp.einsum("bhqk,bkhe->bqhe", a.astype(v.dtype), v)

    o = lax.map(one_block, qb)
    o = o.transpose(1, 0, 2, 3, 4).reshape(B, Nq, N_DIFF_HEADS, V_HEAD_DIM)
    o = rms_norm(o, subln_g) * (1 - lam_init)
    return o.reshape(B, Nq, ATTN_WIDTH)


def chunk_sgu(u, v, ln_g, ln_b, w_s, b_s):
    B, N, _ = v.shape
    vn = layer_norm(v, ln_g, ln_b).reshape(B, N // CHUNK, CHUNK, N_SGU_GROUPS, SGU_GROUP_DIM)
    mixed = jnp.einsum("gij,bnjgc->bnigc", w_s, vn) + b_s.T[None, None, :, :, None]
    return u * mixed.reshape(B, N, SGU_WIDTH)


def gated_merge(h, attn_o, sgu_o, w_gate, b_gate, w_br_attn, w_br_sgu, w_out):
    gates = jax.nn.sigmoid((h @ w_gate + b_gate).astype(jnp.float32)).astype(h.dtype)
    g_attn, g_sgu = jnp.split(gates, 2, axis=-1)
    return (g_attn * (attn_o @ w_br_attn) + g_sgu * (sgu_o @ w_br_sgu)) @ w_out


def sq_relu_ffn(h, w1, w2):
    return jnp.square(jax.nn.relu(h @ w1)) @ w2


def setup_inputs(seed: int = 0) -> dict:
    key = jax.random.key(seed)
    ks = jax.random.split(key, 26)
    L = DEPTH

    def nrm(k, shape, s):
        return jax.random.normal(k, shape, jnp.float32) * s

    return {
        "x": nrm(ks[0], (BATCH, SEQ, D_MODEL), 1.0),
        "c": nrm(ks[1], (BATCH, D_MODEL), 1.0),
        "ctx": nrm(ks[2], (BATCH, CTX_LEN, D_MODEL), 1.0),
        "c_ctx": nrm(ks[3], (D_MODEL,), 1.0),
        "w_ada": nrm(ks[4], (L, D_MODEL, 6 * D_MODEL), 0.5 * D_MODEL ** -0.5),
        "b_ada": nrm(ks[5], (L, 6 * D_MODEL), 0.01),
        "norm1_g": 1.0 + nrm(ks[6], (L, D_MODEL), 0.02),
        "norm2_g": 1.0 + nrm(ks[7], (L, D_MODEL), 0.02),
        "w_in": nrm(ks[8], (L, D_MODEL, IN_WIDTH), D_MODEL ** -0.5),
        "lam_q1": nrm(ks[9], (L, HEAD_DIM), 0.1),
        "lam_k1": nrm(ks[10], (L, HEAD_DIM), 0.1),
        "lam_q2": nrm(ks[11], (L, HEAD_DIM), 0.1),
        "lam_k2": nrm(ks[12], (L, HEAD_DIM), 0.1),
        "subln_g": 1.0 + nrm(ks[13], (L, V_HEAD_DIM), 0.02),
        "sgu_ln_g": 1.0 + nrm(ks[14], (L, SGU_WIDTH), 0.02),
        "sgu_ln_b": nrm(ks[15], (L, SGU_WIDTH), 0.02),
        "w_spatial": nrm(ks[16], (L, N_SGU_GROUPS, CHUNK, CHUNK), 0.5 * CHUNK ** -0.5),
        "b_spatial": 1.0 + nrm(ks[17], (L, N_SGU_GROUPS, CHUNK), 0.02),
        "w_gate": nrm(ks[18], (L, D_MODEL, 2 * D_MODEL), D_MODEL ** -0.5),
        "b_gate": nrm(ks[19], (L, 2 * D_MODEL), 0.01),
        "w_br_attn": nrm(ks[20], (L, ATTN_WIDTH, D_MODEL), ATTN_WIDTH ** -0.5),
        "w_br_sgu": nrm(ks[21], (L, SGU_WIDTH, D_MODEL), SGU_WIDTH ** -0.5),
        "w_out": nrm(ks[22], (L, D_MODEL, D_MODEL), D_MODEL ** -0.5),
        "w_ff1": nrm(ks[23], (L, D_MODEL, FF_DIM), D_MODEL ** -0.5),
        "w_ff2": nrm(ks[24], (L, FF_DIM, D_MODEL), FF_DIM ** -0.5),
        "final_g": 1.0 + nrm(ks[25], (D_MODEL,), 0.02),
    }


def reference(x, c, ctx, c_ctx, w_ada, b_ada, norm1_g, norm2_g, w_in,
              lam_q1, lam_k1, lam_q2, lam_k2, subln_g, sgu_ln_g, sgu_ln_b,
              w_spatial, b_spatial, w_gate, b_gate, w_br_attn, w_br_sgu, w_out,
              w_ff1, w_ff2, final_g):
    B, N, _ = x.shape
    Lc = ctx.shape[1]
    A = ATTN_WIDTH
    H2 = 2 * N_DIFF_HEADS
    cos, sin = axial_rope_tables(N)
    cx = ctx
    for l in range(DEPTH):
        lam_init = 0.8 - 0.6 * math.exp(-0.3 * l)
        lam = (jnp.exp(jnp.sum((lam_q1[l] * lam_k1[l]).astype(jnp.float32)))
               - jnp.exp(jnp.sum((lam_q2[l] * lam_k2[l]).astype(jnp.float32))) + lam_init)
        mod_x = jax.nn.silu(c) @ w_ada[l] + b_ada[l]
        mod_c = jax.nn.silu(c_ctx) @ w_ada[l] + b_ada[l]
        sh1, sc1, g1, sh2, sc2, g2 = [m[:, None, :] for m in jnp.split(mod_x, 6, axis=-1)]
        csh1, csc1, cg1, csh2, csc2, cg2 = jnp.split(mod_c, 6, axis=-1)

        hx = modulated_norm(x, norm1_g[l], sh1, sc1)
        hc = modulated_norm(cx, norm1_g[l], csh1, csc1)
        w_l = w_in[l]
        proj_x = hx @ w_l
        qx = apply_rope(proj_x[..., :A].reshape(B, N, H2, HEAD_DIM), cos, sin)
        kx = apply_rope(proj_x[..., A:2 * A].reshape(B, N, H2, HEAD_DIM), cos, sin)
        vx = proj_x[..., 2 * A:3 * A].reshape(B, N, N_DIFF_HEADS, V_HEAD_DIM)
        ux, vsx = jnp.split(jax.nn.gelu(proj_x[..., 3 * A:]), 2, axis=-1)
        kc = (hc @ w_l[:, A:2 * A]).reshape(B, Lc, H2, HEAD_DIM)
        vc = (hc @ w_l[:, 2 * A:3 * A]).reshape(B, Lc, N_DIFF_HEADS, V_HEAD_DIM)
        k_all = jnp.concatenate([kc, kx], axis=1)
        v_all = jnp.concatenate([vc, vx], axis=1)
        ax = diff_attention(qx, k_all, v_all, lam, lam_init, subln_g[l])
        sx = chunk_sgu(ux, vsx, sgu_ln_g[l], sgu_ln_b[l], w_spatial[l], b_spatial[l])
        x = x + g1 * gated_merge(hx, ax, sx, w_gate[l], b_gate[l], w_br_attn[l], w_br_sgu[l], w_out[l])

        x = x + g2 * sq_relu_ffn(modulated_norm(x, norm2_g[l], sh2, sc2), w_ff1[l], w_ff2[l])

        if l < DEPTH - 1:
            qc = (hc @ w_l[:, :A]).reshape(B, Lc, H2, HEAD_DIM)
            uc, vsc = jnp.split(jax.nn.gelu(hc @ w_l[:, 3 * A:]), 2, axis=-1)
            ac = diff_attention(qc, kc, vc, lam, lam_init, subln_g[l])
            scx = chunk_sgu(uc, vsc, sgu_ln_g[l], sgu_ln_b[l], w_spatial[l], b_spatial[l])
            cx = cx + cg1 * gated_merge(hc, ac, scx, w_gate[l], b_gate[l], w_br_attn[l], w_br_sgu[l], w_out[l])
            cx = cx + cg2 * sq_relu_ffn(modulated_norm(cx, norm2_g[l], csh2, csc2), w_ff1[l], w_ff2[l])
    return rms_norm(x, final_g)
```

```cpp
#include <hip/hip_runtime.h>
#include <cstdio>
#include <cstdint>

#define GAS __attribute__((address_space(1)))
#define LAS __attribute__((address_space(3)))
typedef unsigned short bf16_t;
typedef float f32x4 __attribute__((ext_vector_type(4)));
typedef float f32x2 __attribute__((ext_vector_type(2)));
typedef unsigned u32x4 __attribute__((ext_vector_type(4)));
typedef unsigned u32x2 __attribute__((ext_vector_type(2)));

constexpr int DM = 2048, SEQ = 8192, CTXL = 256, NKV = SEQ + CTXL, AW = 1024, SW = 1024, INW = 5120, GWD = 4096, NPROJ = INW + GWD, FFD = 8192;
constexpr int NH = 8, NSUB = 16, HD = 64, VD = 128, NGRP = 8, CHUNK = 128;
constexpr float EPS = 1e-6f, LAM_INIT = 0.2f;

constexpr size_t MiB = 1u << 20, KiB = 1u << 10;
constexpr size_t WS_CTL = 0, WS_MODX = 64 * KiB, WS_MODC = 112 * KiB, WS_ROPE = 128 * KiB, WS_LAM = 144 * KiB;
constexpr size_t WS_WIG = 1 * MiB, WS_WBA = 37 * MiB, WS_WBS = 41 * MiB, WS_WOUT = 45 * MiB, WS_WFF1 = 53 * MiB, WS_WFF2 = 85 * MiB;
constexpr size_t WS_AALL = 117 * MiB, WS_AX = 117 * MiB, WS_SX = 133 * MiB, WS_H2 = 117 * MiB;
constexpr size_t WS_Q = 150 * MiB, WS_K = 166 * MiB, WS_V = WS_K + (size_t)NKV * AW * 2, WS_U = 199 * MiB, WS_VS = 215 * MiB;
constexpr size_t WS_P = 150 * MiB, WS_X1 = 150 * MiB, WS_G = 231 * MiB, WS_T = 295 * MiB, WS_F = 214 * MiB, WS_OSUB = 295 * MiB;
constexpr size_t WS_END = 360 * MiB;
static_assert(WS_V + (size_t)NKV * AW * 2 <= WS_U, "ws map");

struct Ctx {
    const float *x, *c, *ctx, *c_ctx, *w_ada, *b_ada, *norm1_g, *norm2_g, *w_in, *lam_q1, *lam_k1, *lam_q2, *lam_k2, *subln_g, *sgu_ln_g, *sgu_ln_b,
        *w_spatial, *b_spatial, *w_gate, *b_gate, *w_br_attn, *w_br_sgu, *w_out, *w_ff1, *w_ff2, *final_g;
    float* out; unsigned char* ws;
};

__device__ __forceinline__ float bf2f(bf16_t b) { return __uint_as_float((unsigned)b << 16); }
__device__ __forceinline__ unsigned f2bf(float f) { unsigned u = __float_as_uint(f); return (u + 0x7fffu + ((u >> 16) & 1u)) >> 16; }
__device__ __forceinline__ unsigned pk2(float lo, float hi) { return f2bf(lo) | (f2bf(hi) << 16); }
__device__ __forceinline__ float wave_sum(float v) {
#pragma unroll
    for (int o = 1; o < 64; o <<= 1) v += __shfl_xor(v, o);
    return v;
}
__device__ __forceinline__ float gelu_tanh(float v) {
    const float u = 0.7978845608028654f * (v + 0.044715f * v * v * v);
    return v / (1.f + __expf(-2.f * u));
}
__device__ __forceinline__ float sigmoidf_(float v) { return 1.f / (1.f + __expf(-v)); }

__device__ __forceinline__ void p0_gemv_item(const Ctx& C, int item, LAS float* scr, int tid) {
    const bool isx = item < 192; const int jg = isx ? item : item - 192; const float* vec = isx ? C.c : C.c_ctx;
    float* outp = (float*)(C.ws + (isx ? WS_MODX : WS_MODC));
    for (int k = tid; k < DM; k += 512) { const float v = vec[k]; scr[k] = v / (1.f + expf(-v)); }
    __syncthreads();
    const int lane = tid & 63, w = tid >> 6, cq = lane & 15, rs = w * 4 + (lane >> 4);
    const float* wp = C.w_ada + (size_t)rs * (6 * DM) + jg * 64 + cq * 4;
    f32x4 acc = {0.f, 0.f, 0.f, 0.f};
#pragma unroll 8
    for (int i = 0; i < 64; ++i) { const f32x4 wv = *(const f32x4*)(wp + (size_t)i * 32 * (6 * DM)); acc += wv * scr[rs + 32 * i]; }
    LAS float* red = scr + DM;
    *(LAS f32x4*)(red + rs * 64 + cq * 4) = acc;
    __syncthreads();
    if (tid < 64) { float s = 0.f; for (int r = 0; r < 32; ++r) s += red[r * 64 + tid]; outp[jg * 64 + tid] = s + C.b_ada[jg * 64 + tid]; }
    __syncthreads();
}
__device__ __forceinline__ void p0_transpose_item(const float* W, int K, int N, bf16_t* WT, int row_off, LAS float* scr, int item, int lane) {
    const int nblk = N / 32, kb = item / nblk, nb = item % nblk, k0 = 64 * kb, n0 = 32 * nb;
#pragma unroll 8
    for (int i = 0; i < 32; ++i) { const int kk = 2 * i + (lane >> 5); scr[kk * 33 + (lane & 31)] = W[(size_t)(k0 + kk) * N + n0 + (lane & 31)]; }
    asm volatile("s_waitcnt lgkmcnt(0)" ::: "memory");
    const int c = lane & 7;
#pragma unroll
    for (int j = 0; j < 4; ++j) { const int n = (lane >> 3) + 8 * j; const LAS float* s = scr + (8 * c) * 33 + n;
        u32x4 o; o.x = pk2(s[0 * 33], s[1 * 33]); o.y = pk2(s[2 * 33], s[3 * 33]); o.z = pk2(s[4 * 33], s[5 * 33]); o.w = pk2(s[6 * 33], s[7 * 33]);
        *(u32x4*)(WT + (size_t)(row_off + n0 + n) * K + k0 + 8 * c) = o; }
    asm volatile("s_waitcnt lgkmcnt(0)" ::: "memory");
}
__device__ __forceinline__ void p0_small(const Ctx& C, int tid) {
    const double INV[16] = {1.0, 0.5623413251903491, 0.31622776601683794, 0.1778279410038923, 0.1, 0.05623413251903491, 0.03162277660168379, 0.01778279410038923,
                            0.01, 0.005623413251903491, 0.0031622776601683794, 0.0017782794100389228, 0.001, 0.0005623413251903491, 0.00031622776601683794, 0.00017782794100389227};
    f32x2* tab = (f32x2*)(C.ws + WS_ROPE);
    for (int e = tid; e < 128 * 16; e += 512) {
        const int pos = e >> 4, i = e & 15;
        double inv = 0.0;
#pragma unroll
        for (int q = 0; q < 16; ++q) inv = (i == q) ? INV[q] : inv;
        const double a = (double)pos * inv, k = __builtin_rint(a * 0.15915494309189535), r = __builtin_fma(-k, 6.283185307179586, a), r2 = r * r;
        double cs = 1.0, sn = r, tc = 1.0, ts = r;
        for (int n = 1; n <= 14; ++n) { tc = -tc * r2 / (double)((2 * n - 1) * (2 * n)); ts = -ts * r2 / (double)((2 * n) * (2 * n + 1)); cs += tc; sn += ts; }
        tab[e] = (f32x2){(float)cs, (float)sn};
    }
    if (tid == 0) {
        float a = 0.f, b = 0.f;
        for (int i = 0; i < HD; ++i) { a += C.lam_q1[i] * C.lam_k1[i]; b += C.lam_q2[i] * C.lam_k2[i]; }
        *(float*)(C.ws + WS_LAM) = expf(a) - expf(b) + LAM_INIT;
    }
}
__device__ __forceinline__ void phase0(const Ctx& C, LAS unsigned char* lds) {
    const int tid = threadIdx.x, lane = tid & 63, wave = tid >> 6, G = gridDim.x, b = blockIdx.x;
    for (int it = b; it < 256; it += G) p0_gemv_item(C, it, (LAS float*)lds, tid);
    if (b == G - 1) p0_small(C, tid);
    LAS float* scr = (LAS float*)(lds + wave * 16384);
    const int gw = b * 8 + wave, NGW = G * 8;
    constexpr int I_IN = (DM / 64) * (INW / 32), I_G = (DM / 64) * (GWD / 32), I_BA = (AW / 64) * (DM / 32), I_O = (DM / 64) * (DM / 32), I_1 = (DM / 64) * (FFD / 32), I_2 = (FFD / 64) * (DM / 32);
    constexpr int NIT = I_IN + I_G + 2 * I_BA + I_O + I_1 + I_2;
    for (int it = gw; it < NIT; it += NGW) {
        int r = it;
        if (r < I_IN) { p0_transpose_item(C.w_in, DM, INW, (bf16_t*)(C.ws + WS_WIG), 0, scr, r, lane); continue; } r -= I_IN;
        if (r < I_G) { p0_transpose_item(C.w_gate, DM, GWD, (bf16_t*)(C.ws + WS_WIG), INW, scr, r, lane); continue; } r -= I_G;
        if (r < I_BA) { p0_transpose_item(C.w_br_attn, AW, DM, (bf16_t*)(C.ws + WS_WBA), 0, scr, r, lane); continue; } r -= I_BA;
        if (r < I_BA) { p0_transpose_item(C.w_br_sgu, SW, DM, (bf16_t*)(C.ws + WS_WBS), 0, scr, r, lane); continue; } r -= I_BA;
        if (r < I_O) { p0_transpose_item(C.w_out, DM, DM, (bf16_t*)(C.ws + WS_WOUT), 0, scr, r, lane); continue; } r -= I_O;
        if (r < I_1) { p0_transpose_item(C.w_ff1, DM, FFD, (bf16_t*)(C.ws + WS_WFF1), 0, scr, r, lane); continue; } r -= I_1;
        p0_transpose_item(C.w_ff2, FFD, DM, (bf16_t*)(C.ws + WS_WFF2), 0, scr, r, lane);
    }
}

__device__ __forceinline__ void modnorm_row(const float* xrow, const float* g, const float* scale, const float* shift, bf16_t* orow, int lane) {
    f32x4 v[8]; float s = 0.f;
#pragma unroll
    for (int j = 0; j < 8; ++j) { v[j] = *(const f32x4*)(xrow + (lane + 64 * j) * 4); s += (v[j].x * v[j].x + v[j].y * v[j].y) + (v[j].z * v[j].z + v[j].w * v[j].w); }
    const float rinv = 1.0f / sqrtf(wave_sum(s) * (1.f / DM) + EPS);
#pragma unroll
    for (int j = 0; j < 8; ++j) {
        const int c = (lane + 64 * j) * 4;
        const f32x4 gv = *(const f32x4*)(g + c), sc = *(const f32x4*)(scale + c), sh = *(const f32x4*)(shift + c);
        const f32x4 o = (v[j] * rinv) * gv * (sc + 1.0f) + sh;
        u32x2 w; w.x = pk2(o.x, o.y); w.y = pk2(o.z, o.w);
        *(u32x2*)(orow + c) = w;
    }
}
__device__ __forceinline__ void phase1(const Ctx& C) {
    const int lane = threadIdx.x & 63, gw = blockIdx.x * 8 + (threadIdx.x >> 6), NGW = gridDim.x * 8;
    const float* modx = (const float*)(C.ws + WS_MODX); const float* modc = (const float*)(C.ws + WS_MODC);
    bf16_t* A = (bf16_t*)(C.ws + WS_AALL);
    for (int r = gw; r < NKV; r += NGW) {
        if (r < CTXL) modnorm_row(C.ctx + (size_t)r * DM, C.norm1_g, modc + DM, modc, A + (size_t)r * DM, lane);
        else modnorm_row(C.x + (size_t)(r - CTXL) * DM, C.norm1_g, modx + DM, modx, A + (size_t)r * DM, lane);
    }
}
__device__ __forceinline__ void phase_h2(const Ctx& C) {
    const int lane = threadIdx.x & 63, gw = blockIdx.x * 8 + (threadIdx.x >> 6), NGW = gridDim.x * 8;
    const float* modx = (const float*)(C.ws + WS_MODX);
    const float* X1 = (const float*)(C.ws + WS_X1); bf16_t* H2 = (bf16_t*)(C.ws + WS_H2);
    for (int r = gw; r < SEQ; r += NGW) modnorm_row(X1 + (size_t)r * DM, C.norm2_g, modx + 4 * DM, modx + 3 * DM, H2 + (size_t)r * DM, lane);
}
__device__ __forceinline__ void phase_final(const Ctx& C) {
    const int lane = threadIdx.x & 63, gw = blockIdx.x * 8 + (threadIdx.x >> 6), NGW = gridDim.x * 8;
    for (int r = gw; r < SEQ; r += NGW) {
        float* xrow = C.out + (size_t)r * DM;
        f32x4 v[8]; float s = 0.f;
#pragma unroll
        for (int j = 0; j < 8; ++j) { v[j] = *(const f32x4*)(xrow + (lane + 64 * j) * 4); s += (v[j].x * v[j].x + v[j].y * v[j].y) + (v[j].z * v[j].z + v[j].w * v[j].w); }
        const float rinv = 1.0f / sqrtf(wave_sum(s) * (1.f / DM) + EPS);
#pragma unroll
        for (int j = 0; j < 8; ++j) { const int c = (lane + 64 * j) * 4; *(f32x4*)(xrow + c) = (v[j] * rinv) * *(const f32x4*)(C.final_g + c); }
    }
}

namespace pg8 {
typedef short bf16x8 __attribute__((ext_vector_type(8)));
constexpr int BM = 256, BK = 64, HALF = 128, HTB = HALF * BK * 2  , STAGE_BYTES = 8 * HTB, NXCD = 8, WGM = 8;
__device__ __forceinline__ int lds_byte(int r, int c) { const int st = (r >> 4) * 2 + (c >> 5), rr = r & 15, cc = c & 31, ob = rr * 64 + cc * 2; return st * 1024 + (ob ^ (((ob >> 9) & 1) << 5)); }
__device__ __forceinline__ void stage_rc(int b, int& R, int& C) { const int st = b / 1024, sb = b % 1024, swz = sb ^ (((sb >> 9) & 1) << 5); R = (st >> 1) * 16 + swz / 64; C = (st & 1) * 32 + (swz % 64) / 2; }
__device__ __forceinline__ int perm32(int rho) { const int n = rho >> 4, i = rho & 15; return 8 * (i >> 2) + 4 * n + (i & 3); }

struct Unit { int pm, pn, z; };

struct GridSched {
    int nM, nN, nz, G, c; const char *A0, *A1, *B0, *B1; size_t tstep;
    __device__ __forceinline__ bool next(int i, Unit& u) const {
        const int ti = i / nz; u.z = i - ti * nz;
        const int nwg = nM * nN; const long L = (long)ti * G + c; if (L >= nwg) return false;
        int wgid = (int)L; { const int q = nwg / NXCD, r = nwg % NXCD, xcd = wgid % NXCD, off = wgid / NXCD; wgid = (xcd < r ? xcd * (q + 1) : r * (q + 1) + (xcd - r) * q) + off; }
        const int nig = WGM * nN, gid = wgid / nig, fm = gid * WGM, gsz = (nM - fm) < WGM ? (nM - fm) : WGM;
        u.pm = fm + ((wgid % nig) % gsz); u.pn = (wgid % nig) / gsz; return true;
    }
    __device__ __forceinline__ const char* aptr(const Unit& u) const { return (u.z ? A1 : A0) + (size_t)u.pm * tstep; }
    __device__ __forceinline__ const char* bptr(const Unit& u) const { return (u.z ? B1 : B0) + (size_t)u.pn * tstep; }
};
struct ProjSched {
    int G, c; const char *A, *B; size_t tstep;
    __device__ __forceinline__ bool next(int i, Unit& u) const {
        constexpr int NW = 32 * 36 + 8;
        const long L = (long)i * G + c; if (L >= NW) return false;
        const int wgid = (int)(L % NXCD) * (NW / NXCD) + (int)(L / NXCD); u.z = 0;
        if (wgid >= 32 * 36) { u.pm = 0; u.pn = 4 + (wgid - 32 * 36); }
        else { const int nig = WGM * 36, gid = wgid / nig, r = wgid % nig; u.pm = 1 + gid * WGM + (r % WGM); u.pn = r / WGM; }
        return true;
    }
    __device__ __forceinline__ const char* aptr(const Unit& u) const { return A + (size_t)u.pm * tstep; }
    __device__ __forceinline__ const char* bptr(const Unit& u) const { return B + (size_t)u.pn * tstep; }
};

template <class Epi> __device__ __forceinline__ void run_epi(const Epi& E, const f32x4 (&acc)[2][2][4][2], const Unit& u, int wr, int wc, int fr, int fq) {
    const int row0 = u.pm * BM + wr * 64 + fr, col0 = u.pn * BM + wc * 32 + 8 * fq;
#pragma unroll
    for (int ai = 0; ai < 2; ++ai)
#pragma unroll
        for (int m = 0; m < 4; ++m)
#pragma unroll
            for (int bj = 0; bj < 2; ++bj)
#pragma unroll
                for (int n = 0; n < 2; ++n) E(u, row0 + ai * HALF + m * 16, col0 + bj * HALF + 4 * n, acc[ai][bj][m][n]);
}

template <class Epi, class Sched>
__device__ __forceinline__ void gemm_phase(LAS unsigned char* lds, const int K, const Sched& S, const Epi& E) {
    const int tid = threadIdx.x, wid = __builtin_amdgcn_readfirstlane(tid >> 6), lane = tid & 63, wr = wid >> 2, wc = wid & 3, fr = lane & 15, fq = lane >> 4;
    const int nt = K / BK;
    unsigned voffA[2], voffB[2];
#pragma unroll
    for (int i = 0; i < 2; ++i) { int R, C; stage_rc(tid * 16 + i * 8192, R, C); const int Rb = (R & ~31) + perm32(R & 31);
        voffA[i] = (unsigned)(R * K + C) * 2u; voffB[i] = (unsigned)(Rb * K + C) * 2u; }
    const size_t kstep = (size_t)(BK * 2);
    const size_t hstep = (size_t)HALF * K * 2;
    const unsigned ldsw = (unsigned)wid * 1024u;
    const int aoff = lds_byte(wr * 64 + fr, fq * 8), boff = lds_byte(wc * 32 + fr, fq * 8);
#define PG8_SA(b, h) (((b) * 2 + (h)) * HTB)
#define PG8_SB(b, h) ((4 + (b) * 2 + (h)) * HTB)
#define PG8_STAGE(bufoff, gbase, voff) do { _Pragma("unroll") for (int _i = 0; _i < 2; ++_i) \
        __builtin_amdgcn_global_load_lds((const unsigned*)((const char*)(gbase) + (voff)[_i]), (LAS unsigned*)(lds + (bufoff) + ldsw + _i * 8192), 16, 0, 0); } while (0)
#define PG8_LDA(dst, b, h) do { _Pragma("unroll") for (int m = 0; m < 4; ++m) _Pragma("unroll") for (int k = 0; k < 2; ++k) dst[m][k] = *(const LAS bf16x8*)(lds + PG8_SA(b, h) + aoff + m * 2048 + k * 1024); } while (0)
#define PG8_LDB(dst, b, h) do { _Pragma("unroll") for (int n = 0; n < 2; ++n) _Pragma("unroll") for (int k = 0; k < 2; ++k) dst[n][k] = *(const LAS bf16x8*)(lds + PG8_SB(b, h) + boff + n * 2048 + k * 1024); } while (0)
#define PG8_MMA(ai, bj, At, Bt) do { __builtin_amdgcn_s_setprio(1); _Pragma("unroll") for (int m = 0; m < 4; ++m) _Pragma("unroll") for (int n = 0; n < 2; ++n) _Pragma("unroll") for (int k = 0; k < 2; ++k) \
        acc[ai][bj][m][n] = __builtin_amdgcn_mfma_f32_16x16x32_bf16(Bt[n][k], At[m][k], acc[ai][bj][m][n], 0, 0, 0); __builtin_amdgcn_s_setprio(0); } while (0)
#define PG8_WAIT_V(n) asm volatile("s_waitcnt vmcnt(" #n ")" ::: "memory")
#define PG8_WAIT_L(n) asm volatile("s_waitcnt lgkmcnt(" #n ")" ::: "memory")
#define PG8_BAR __builtin_amdgcn_s_barrier()
#define PG8_SCHED __builtin_amdgcn_sched_barrier(0)
    Unit cur, nxt; int ui = 0;
    if (!S.next(0, cur)) return;
    f32x4 acc[2][2][4][2];
#pragma unroll
    for (int a = 0; a < 2; ++a)
#pragma unroll
        for (int b = 0; b < 2; ++b)
#pragma unroll
            for (int m = 0; m < 4; ++m)
#pragma unroll
                for (int n = 0; n < 2; ++n) acc[a][b][m][n] = (f32x4){0.f, 0.f, 0.f, 0.f};
    bf16x8 At[4][2], B0[2][2], B1[2][2];
    const char* cA = S.aptr(cur); const char* cB = S.bptr(cur);
    PG8_STAGE(PG8_SB(0, 0), cB, voffB); PG8_STAGE(PG8_SB(0, 1), cB + hstep, voffB); PG8_STAGE(PG8_SA(0, 0), cA, voffA); PG8_STAGE(PG8_SA(0, 1), cA + hstep, voffA);
    if (wr == 1) PG8_BAR;
    PG8_WAIT_V(2); PG8_BAR;
    PG8_STAGE(PG8_SB(1, 0), cB + kstep, voffB); PG8_STAGE(PG8_SA(1, 0), cA + kstep, voffA); PG8_STAGE(PG8_SB(1, 1), cB + hstep + kstep, voffB);
    PG8_WAIT_V(6); PG8_BAR;
    for (;;) {
        const bool has_next = S.next(ui + 1, nxt);
        const char* nA = has_next ? S.aptr(nxt) : cA; const char* nB = has_next ? S.bptr(nxt) : cB;
        for (int t = 0; t < nt; t += 2) {
            const bool last = (t == nt - 2);
            const char* a1 = cA + (size_t)(t + 1) * kstep;
            const char* a2 = last ? nA : cA + (size_t)(t + 2) * kstep; const char* b2 = last ? nB : cB + (size_t)(t + 2) * kstep;
            const char* a3 = a2 + kstep; const char* b3 = b2 + kstep;
            PG8_LDB(B0, 0, 0); PG8_LDB(B1, 0, 1); PG8_SCHED; PG8_LDA(At, 0, 0); PG8_STAGE(PG8_SA(1, 1), a1 + hstep, voffA);
            PG8_WAIT_V(8); PG8_WAIT_L(0); PG8_BAR; PG8_MMA(0, 0, At, B0); PG8_MMA(0, 1, At, B1); PG8_BAR; PG8_SCHED;
            PG8_LDA(At, 0, 1); PG8_STAGE(PG8_SB(0, 0), b2, voffB); PG8_STAGE(PG8_SB(0, 1), b2 + hstep, voffB); PG8_STAGE(PG8_SA(0, 0), a2, voffA);
            PG8_WAIT_V(8); PG8_WAIT_L(0); PG8_BAR; PG8_MMA(1, 0, At, B0); PG8_MMA(1, 1, At, B1); PG8_BAR; PG8_SCHED;
            PG8_LDB(B0, 1, 0); PG8_LDB(B1, 1, 1); PG8_SCHED; PG8_LDA(At, 1, 0); PG8_STAGE(PG8_SA(0, 1), a2 + hstep, voffA);
            PG8_WAIT_V(8); PG8_WAIT_L(0); PG8_BAR; PG8_MMA(0, 0, At, B0); PG8_MMA(0, 1, At, B1); PG8_BAR; PG8_SCHED;
            PG8_LDA(At, 1, 1); PG8_STAGE(PG8_SB(1, 0), b3, voffB); PG8_STAGE(PG8_SB(1, 1), b3 + hstep, voffB); PG8_STAGE(PG8_SA(1, 0), a3, voffA);
            PG8_WAIT_V(8); PG8_WAIT_L(0); PG8_BAR; PG8_MMA(1, 0, At, B0); PG8_MMA(1, 1, At, B1); PG8_BAR; PG8_SCHED;
        }
        if (wr == 0) PG8_BAR;
        run_epi(E, acc, cur, wr, wc, fr, fq);
        if (!has_next) break;
#pragma unroll
        for (int a = 0; a < 2; ++a)
#pragma unroll
            for (int b = 0; b < 2; ++b)
#pragma unroll
                for (int m = 0; m < 4; ++m)
#pragma unroll
                    for (int n = 0; n < 2; ++n) acc[a][b][m][n] = (f32x4){0.f, 0.f, 0.f, 0.f};
        cur = nxt; cA = nA; cB = nB; ++ui;
        if (wr == 1) PG8_BAR;
    }
    PG8_WAIT_V(0);
    PG8_BAR;
#undef PG8_SA
#undef PG8_SB
#undef PG8_STAGE
#undef PG8_LDA
#undef PG8_LDB
#undef PG8_MMA
#undef PG8_WAIT_V
#undef PG8_WAIT_L
#undef PG8_BAR
#undef PG8_SCHED
}
}

__device__ __forceinline__ void st_bf16x4(bf16_t* p, f32x4 o) { u32x2 w; w.x = pk2(o.x, o.y); w.y = pk2(o.z, o.w); *(u32x2*)p = w; }
struct EpiProj {
    unsigned char* ws; const float* b_gate;
    __device__ __forceinline__ f32x4 rope(f32x4 v, int n, int c) const {
        const int cih = c & 63, p0 = cih >> 1, pos = (p0 < 16) ? (n >> 6) : (n & 63), i0 = p0 & 15;
        const f32x4 t = *(const f32x4*)((const float*)(ws + WS_ROPE) + (pos * 16 + i0) * 2);
        return (f32x4){v.x * t.x - v.y * t.y, v.x * t.y + v.y * t.x, v.z * t.z - v.w * t.w, v.z * t.w + v.w * t.z};
    }
    __device__ __forceinline__ void operator()(const pg8::Unit& u, int row, int col, f32x4 v) const {
        const int n = row - CTXL;
        if (col < AW) { st_bf16x4((bf16_t*)(ws + WS_Q) + (size_t)n * AW + col, rope(v, n, col)); }
        else if (col < 2 * AW) { const int c = col - AW; st_bf16x4((bf16_t*)(ws + WS_K) + (size_t)row * AW + c, n >= 0 ? rope(v, n, c) : v); }
        else if (col < 3 * AW) { st_bf16x4((bf16_t*)(ws + WS_V) + (size_t)row * AW + (col - 2 * AW), v); }
        else if (col < 3 * AW + SW) { st_bf16x4((bf16_t*)(ws + WS_U) + (size_t)n * SW + (col - 3 * AW), (f32x4){gelu_tanh(v.x), gelu_tanh(v.y), gelu_tanh(v.z), gelu_tanh(v.w)}); }
        else if (col < INW) { st_bf16x4((bf16_t*)(ws + WS_VS) + (size_t)n * SW + (col - 3 * AW - SW), (f32x4){gelu_tanh(v.x), gelu_tanh(v.y), gelu_tanh(v.z), gelu_tanh(v.w)}); }
        else { const int c = col - INW; const f32x4 b = *(const f32x4*)(b_gate + c);
            st_bf16x4((bf16_t*)(ws + WS_G) + (size_t)n * GWD + c, (f32x4){sigmoidf_(v.x + b.x), sigmoidf_(v.y + b.y), sigmoidf_(v.z + b.z), sigmoidf_(v.w + b.w)}); }
    }
};
__device__ __forceinline__ f32x4 ld_bf16x4(const bf16_t* p) { const u32x2 w = *(const u32x2*)p; return (f32x4){__uint_as_float(w.x << 16), __uint_as_float(w.x & 0xffff0000u), __uint_as_float(w.y << 16), __uint_as_float(w.y & 0xffff0000u)}; }
struct EpiMerge { unsigned char* ws;
    __device__ __forceinline__ void operator()(const pg8::Unit& u, int row, int col, f32x4 v) const {
        float* pp = (float*)(ws + WS_P) + (size_t)row * DM + col;
        if (u.z == 0) { const f32x4 g = ld_bf16x4((const bf16_t*)(ws + WS_G) + (size_t)row * GWD + col); *(f32x4*)pp = g * v; }
        else { const f32x4 g = ld_bf16x4((const bf16_t*)(ws + WS_G) + (size_t)row * GWD + DM + col); const f32x4 p = *(const f32x4*)pp;
            st_bf16x4((bf16_t*)(ws + WS_T) + (size_t)row * DM + col, p + g * v); } } };
struct EpiOut { unsigned char* ws; const float* x;
    __device__ __forceinline__ void operator()(const pg8::Unit& u, int row, int col, f32x4 v) const {
        const f32x4 g = *(const f32x4*)((const float*)(ws + WS_MODX) + 2 * DM + col);
        *(f32x4*)((float*)(ws + WS_X1) + (size_t)row * DM + col) = *(const f32x4*)(x + (size_t)row * DM + col) + g * v; } };
struct EpiFF1 { unsigned char* ws;
    __device__ __forceinline__ void operator()(const pg8::Unit& u, int row, int col, f32x4 v) const {
        const f32x4 r = {fmaxf(v.x, 0.f), fmaxf(v.y, 0.f), fmaxf(v.z, 0.f), fmaxf(v.w, 0.f)};
        st_bf16x4((bf16_t*)(ws + WS_F) + (size_t)row * FFD + col, r * r); } };
struct EpiFF2 { unsigned char* ws; float* out;
    __device__ __forceinline__ void operator()(const pg8::Unit& u, int row, int col, f32x4 v) const {
        const f32x4 g = *(const f32x4*)((const float*)(ws + WS_MODX) + 5 * DM + col);
        *(f32x4*)(out + (size_t)row * DM + col) = *(const f32x4*)((const float*)(ws + WS_X1) + (size_t)row * DM + col) + g * v; } };

__global__ __launch_bounds__(256) void naive_attn(Ctx C) {
    __shared__ float Ks[16][64], Vs[16][128];
    const int tid = threadIdx.x, sub = blockIdx.y, h = sub >> 1, row = blockIdx.x * 256 + tid;
    const bf16_t* Q = (const bf16_t*)(C.ws + WS_Q); const bf16_t* Kb = (const bf16_t*)(C.ws + WS_K); const bf16_t* Vb = (const bf16_t*)(C.ws + WS_V);
    float q[64], o[128];
#pragma unroll
    for (int d = 0; d < 64; d += 4) { const f32x4 t = ld_bf16x4(Q + (size_t)row * AW + sub * 64 + d); q[d] = t.x * 0.125f; q[d + 1] = t.y * 0.125f; q[d + 2] = t.z * 0.125f; q[d + 3] = t.w * 0.125f; }
#pragma unroll
    for (int d = 0; d < 128; ++d) o[d] = 0.f;
    float m = -1e30f, l = 0.f;
    for (int k0 = 0; k0 < NKV; k0 += 16) {
        __syncthreads();
        { const int kr = tid >> 4, kc = (tid & 15) * 4; const f32x4 t = ld_bf16x4(Kb + (size_t)(k0 + kr) * AW + sub * 64 + kc); *(f32x4*)&Ks[kr][kc] = t; }
        { const int vr = tid >> 4, vc = (tid & 15) * 8; const f32x4 t0 = ld_bf16x4(Vb + (size_t)(k0 + vr) * AW + h * 128 + vc), t1 = ld_bf16x4(Vb + (size_t)(k0 + vr) * AW + h * 128 + vc + 4);
          *(f32x4*)&Vs[vr][vc] = t0; *(f32x4*)&Vs[vr][vc + 4] = t1; }
        __syncthreads();
        float s[16]; float tm = -1e30f;
#pragma unroll
        for (int j = 0; j < 16; ++j) { float a = 0.f;
#pragma unroll
            for (int d = 0; d < 64; d += 4) { const f32x4 kv = *(const f32x4*)&Ks[j][d]; a += q[d] * kv.x + q[d + 1] * kv.y + q[d + 2] * kv.z + q[d + 3] * kv.w; }
            s[j] = a; tm = fmaxf(tm, a); }
        const float mn = fmaxf(m, tm), alpha = expf(m - mn); m = mn; l *= alpha;
#pragma unroll
        for (int d = 0; d < 128; ++d) o[d] *= alpha;
#pragma unroll
        for (int j = 0; j < 16; ++j) { const float p = expf(s[j] - mn); l += p;
#pragma unroll
            for (int d = 0; d < 128; d += 4) { const f32x4 vv = *(const f32x4*)&Vs[j][d]; o[d] += p * vv.x; o[d + 1] += p * vv.y; o[d + 2] += p * vv.z; o[d + 3] += p * vv.w; } }
    }
    const float rl = 1.f / l; float* O = (float*)(C.ws + WS_OSUB) + ((size_t)sub * SEQ + row) * 128;
#pragma unroll
    for (int d = 0; d < 128; d += 4) *(f32x4*)(O + d) = (f32x4){o[d] * rl, o[d + 1] * rl, o[d + 2] * rl, o[d + 3] * rl};
}
__global__ __launch_bounds__(256) void naive_attn_combine(Ctx C) {
    const int lane = threadIdx.x & 63, gw = blockIdx.x * 4 + (threadIdx.x >> 6);
    const int row = gw >> 3, h = gw & 7; if (row >= SEQ) return;
    const float lam = *(const float*)(C.ws + WS_LAM);
    const float* O1 = (const float*)(C.ws + WS_OSUB) + ((size_t)(2 * h) * SEQ + row) * 128; const float* O2 = (const float*)(C.ws + WS_OSUB) + ((size_t)(2 * h + 1) * SEQ + row) * 128;
    const float a = O1[lane * 2] - lam * O2[lane * 2], b = O1[lane * 2 + 1] - lam * O2[lane * 2 + 1];
    const float rinv = 1.f / sqrtf(wave_sum(a * a + b * b) * (1.f / 128.f) + EPS);
    const float ga = C.subln_g[lane * 2], gb = C.subln_g[lane * 2 + 1];
    *(unsigned*)((bf16_t*)(C.ws + WS_AX) + (size_t)row * AW + h * 128 + lane * 2) = pk2(a * rinv * ga * (1.f - LAM_INIT), b * rinv * gb * (1.f - LAM_INIT));
}
__global__ __launch_bounds__(256) void naive_sgu(Ctx C) {
    extern __shared__ float sm[];
    float* vn = sm; float* stats = sm + 128 * 128;
    const int tid = threadIdx.x, lane = tid & 63, w = tid >> 6, chunk = blockIdx.x >> 3, g = blockIdx.x & 7;
    const bf16_t* VS = (const bf16_t*)(C.ws + WS_VS); const bf16_t* U = (const bf16_t*)(C.ws + WS_U);
    for (int t = w; t < 128; t += 4) {
        const bf16_t* vr = VS + (size_t)(chunk * 128 + t) * SW; float v[16]; float s = 0.f;
#pragma unroll
        for (int j = 0; j < 4; ++j) { const f32x4 a = ld_bf16x4(vr + (lane + 64 * j) * 4); v[4 * j] = a.x; v[4 * j + 1] = a.y; v[4 * j + 2] = a.z; v[4 * j + 3] = a.w; s += (a.x + a.y) + (a.z + a.w); }
        const float mean = wave_sum(s) * (1.f / SW); float q = 0.f;
#pragma unroll
        for (int j = 0; j < 16; ++j) { const float d = v[j] - mean; q += d * d; }
        const float rstd = 1.f / sqrtf(wave_sum(q) * (1.f / SW) + EPS);
        if (lane == 0) { stats[2 * t] = mean; stats[2 * t + 1] = rstd; }
    }
    __syncthreads();
    for (int e = tid; e < 128 * 128; e += 256) { const int j = e >> 7, c = e & 127;
        vn[e] = (bf2f(VS[(size_t)(chunk * 128 + j) * SW + g * 128 + c]) - stats[2 * j]) * stats[2 * j + 1] * C.sgu_ln_g[g * 128 + c] + C.sgu_ln_b[g * 128 + c]; }
    __syncthreads();
    const int c = tid & 127, ih = tid >> 7;
    for (int i = ih * 64; i < ih * 64 + 64; ++i) {
        const float* wr = C.w_spatial + ((size_t)g * 128 + i) * 128; float a = 0.f;
        for (int j = 0; j < 128; ++j) a += wr[j] * vn[j * 128 + c];
        a += C.b_spatial[g * 128 + i];
        const size_t oi = (size_t)(chunk * 128 + i) * SW + g * 128 + c;
        ((bf16_t*)(C.ws + WS_SX))[oi] = (bf16_t)f2bf(bf2f(U[oi]) * a);
    }
}

namespace fa {
typedef short bf16x8 __attribute__((ext_vector_type(8)));
typedef short s16x4 __attribute__((ext_vector_type(4)));
typedef float f32x16 __attribute__((ext_vector_type(16)));
constexpr int KVBLK = 64, SHM_V = KVBLK * 128 * 2, SHM_K = KVBLK * 128 * 2, LDK = AW;
constexpr float SCALE = 0.125f, THR = 8.f;
#define KSWZ(row, colB) ((row) * 256 + ((colB) ^ (((row) & 7) << 4)))
#define SBAR() __builtin_amdgcn_sched_barrier(0)
__device__ __forceinline__ int crow(int r, int hi) { return (r & 3) + 8 * (r >> 2) + 4 * hi; }
__device__ __forceinline__ unsigned cvtpk(float lo, float hi) { unsigned r; asm volatile("v_cvt_pk_bf16_f32 %0, %1, %2" : "=v"(r) : "v"(lo), "v"(hi)); return r; }
__device__ __forceinline__ void partialSM(f32x16& p0, f32x16& p1, float& m_reg, float& mn, float& alpha) {
  constexpr float Cc = SCALE * 1.4426950408889634f;
  float pmax = p0[0];
#pragma unroll
  for (int r = 1; r < 16; ++r) pmax = fmaxf(pmax, p0[r]);
#pragma unroll
  for (int r = 0; r < 16; ++r) pmax = fmaxf(pmax, p1[r]);
  { auto rr = __builtin_amdgcn_permlane32_swap(__float_as_uint(pmax), __float_as_uint(pmax), false, false);
    pmax = fmaxf(__uint_as_float(rr[0]), __uint_as_float(rr[1])); }
  if (__builtin_expect(__all(pmax - m_reg <= THR / SCALE), 1)) { mn = m_reg; alpha = 1.f; }
  else { mn = fmaxf(m_reg, pmax); alpha = __builtin_amdgcn_exp2f((m_reg - mn) * Cc); m_reg = mn; }
  const float mnC = -mn * Cc;
#pragma unroll
  for (int r = 0; r < 16; ++r) p0[r] = fmaf(p0[r], Cc, mnC);
#pragma unroll
  for (int r = 0; r < 16; ++r) p1[r] = fmaf(p1[r], Cc, mnC);
#pragma unroll
  for (int r = 0; r < 16; ++r) p0[r] = __builtin_amdgcn_exp2f(p0[r]);
}
__device__ __forceinline__ void finishSM(f32x16& p0, f32x16& p1, float alpha, float& l_reg, bf16x8& pa0, bf16x8& pa1, bf16x8& pa2, bf16x8& pa3) {
#pragma unroll
  for (int r = 0; r < 16; ++r) p1[r] = __builtin_amdgcn_exp2f(p1[r]);
  float ps = 0;
#pragma unroll
  for (int r = 0; r < 16; ++r) ps += p0[r];
#pragma unroll
  for (int r = 0; r < 16; ++r) ps += p1[r];
  { auto rr = __builtin_amdgcn_permlane32_swap(__float_as_uint(ps), __float_as_uint(ps), false, false);
    ps = __uint_as_float(rr[0]) + __uint_as_float(rr[1]); }
  l_reg = l_reg * alpha + ps;
#define PK4(P, BASE, OUT) do { unsigned a0 = cvtpk(P[BASE + 0], P[BASE + 1]), a1 = cvtpk(P[BASE + 2], P[BASE + 3]);   \
    unsigned b0 = cvtpk(P[BASE + 4], P[BASE + 5]), b1 = cvtpk(P[BASE + 6], P[BASE + 7]);                              \
    auto r0 = __builtin_amdgcn_permlane32_swap(a0, b0, false, false); auto r1 = __builtin_amdgcn_permlane32_swap(a1, b1, false, false); \
    u32x4 w = {r0[0], r1[0], r0[1], r1[1]}; OUT = __builtin_bit_cast(bf16x8, w); } while (0)
  PK4(p0, 0, pa0); PK4(p0, 8, pa1); PK4(p1, 0, pa2); PK4(p1, 8, pa3);
#undef PK4
}
__device__ __forceinline__ void qkt(f32x16& p0, f32x16& p1, const LAS unsigned char* Ks, const bf16x8* qr, int r32, int hi, int sub) {
  p0 = f32x16{}; p1 = f32x16{};
#pragma unroll
  for (int d0 = 0; d0 < 4; ++d0) { const int cb = (sub * 64 + d0 * 16 + hi * 8) * 2;
    const bf16x8 b0 = *(const LAS bf16x8*)(Ks + KSWZ(r32, cb));
    const bf16x8 b1 = *(const LAS bf16x8*)(Ks + KSWZ(32 + r32, cb));
    p0 = __builtin_amdgcn_mfma_f32_32x32x16_bf16(b0, qr[d0], p0, 0, 0, 0);
    p1 = __builtin_amdgcn_mfma_f32_32x32x16_bf16(b1, qr[d0], p1, 0, 0, 0); }
}
__device__ __forceinline__ int v_st(int k, int c) { const int kk = (k & ~0xC) | ((k & 4) << 1) | ((k & 8) >> 1); return ((kk >> 3) * 4 + (c >> 5)) * 512 + ((kk & 7) * 32 + (c & 31)) * 2; }
__device__ __forceinline__ int v_rd_base(int lane) { return ((lane & 3) << 3) | (((lane >> 2) & 3) << 6) | (((lane >> 4) & 1) << 5) | (((lane >> 5) & 1) << 8); }
constexpr int v_rd_off(int d0, int ks, int half) { return d0 * 512 + ks * 4096 + half * 2048; }
template <int OFF> __device__ __forceinline__ s16x4 tr_read(int vb) {
  s16x4 r; asm volatile("ds_read_b64_tr_b16 %0, %1 offset:%2" : "=&v"(r) : "v"(vb), "i"(OFF) : "memory"); return r;
}
template <int D0> __device__ __forceinline__ void pv_one(f32x16& od, int vb, bf16x8 pa0, bf16x8 pa1, bf16x8 pa2, bf16x8 pa3) {
  const s16x4 l0 = tr_read<v_rd_off(D0, 0, 0)>(vb), h0 = tr_read<v_rd_off(D0, 0, 1)>(vb), l1 = tr_read<v_rd_off(D0, 1, 0)>(vb), h1 = tr_read<v_rd_off(D0, 1, 1)>(vb);
  const s16x4 l2 = tr_read<v_rd_off(D0, 2, 0)>(vb), h2 = tr_read<v_rd_off(D0, 2, 1)>(vb), l3 = tr_read<v_rd_off(D0, 3, 0)>(vb), h3 = tr_read<v_rd_off(D0, 3, 1)>(vb);
  asm volatile("s_waitcnt lgkmcnt(0)" ::: "memory"); SBAR();
#define PK(L, H) (bf16x8){L[0], L[1], L[2], L[3], H[0], H[1], H[2], H[3]}
  od = __builtin_amdgcn_mfma_f32_32x32x16_bf16(pa0, PK(l0, h0), od, 0, 0, 0);
  od = __builtin_amdgcn_mfma_f32_32x32x16_bf16(pa1, PK(l1, h1), od, 0, 0, 0);
  od = __builtin_amdgcn_mfma_f32_32x32x16_bf16(pa2, PK(l2, h2), od, 0, 0, 0);
  od = __builtin_amdgcn_mfma_f32_32x32x16_bf16(pa3, PK(l3, h3), od, 0, 0, 0);
#undef PK
}
__device__ __forceinline__ void pv_d0(f32x16* o, int vb, bf16x8 pa0, bf16x8 pa1, bf16x8 pa2, bf16x8 pa3) {
  pv_one<0>(o[0], vb, pa0, pa1, pa2, pa3); pv_one<1>(o[1], vb, pa0, pa1, pa2, pa3); pv_one<2>(o[2], vb, pa0, pa1, pa2, pa3); pv_one<3>(o[3], vb, pa0, pa1, pa2, pa3);
}

__device__ __forceinline__ void attn_unit(unsigned char* wsb, const float* subln_g, int h, int qb, LAS unsigned char* lds, float lam) {
  const int tid = threadIdx.x, wid = __builtin_amdgcn_readfirstlane(tid >> 6), lane = tid & 63, r32 = lane & 31, hi = lane >> 5, sub = wid >> 2, qw = wid & 3;
  LAS unsigned char* V_lds = lds; LAS unsigned char* K_lds = lds + 2 * SHM_V;
  LAS float* wsf = (LAS float*)(lds + 2 * SHM_V + 2 * SHM_K) + wid * 64; LAS float* li_l = wsf; LAS float* al_l = wsf + 32;
  const bf16_t* Kh = (const bf16_t*)(wsb + WS_K) + h * 128; const bf16_t* Vh = (const bf16_t*)(wsb + WS_V) + h * 128;
  const int q0 = qb * 128;
  float m_reg = -1e30f, l_reg = 0; f32x16 o[4] = {}; bf16x8 qr[4];
  const bf16_t* Qw = (const bf16_t*)(wsb + WS_Q) + (size_t)(q0 + qw * 32 + r32) * AW + (2 * h + sub) * 64 + hi * 8;
#pragma unroll
  for (int d0 = 0; d0 < 4; ++d0) qr[d0] = *(const bf16x8*)(Qw + d0 * 16);
  const int sr = tid >> 4, sc = (tid & 15) * 8, vst0 = v_st(sr, sc), vst1 = v_st(32 + sr, sc);
  const int vb0 = (int)(size_t)V_lds + v_rd_base(lane);
  struct { bf16x8 vs0, vs1, ks0, ks1; } sr_[2];
#define SLOAD(i, k0) do { sr_[i].vs0 = *(const bf16x8*)(&Vh[(long)((k0) + sr) * LDK + sc]); sr_[i].vs1 = *(const bf16x8*)(&Vh[(long)((k0) + 32 + sr) * LDK + sc]); \
    sr_[i].ks0 = *(const bf16x8*)(&Kh[(long)((k0) + sr) * LDK + sc]); sr_[i].ks1 = *(const bf16x8*)(&Kh[(long)((k0) + 32 + sr) * LDK + sc]); } while (0)
#define SWRITE(b, i) do { *(LAS bf16x8*)(V_lds + (b) * SHM_V + vst0) = sr_[i].vs0; *(LAS bf16x8*)(V_lds + (b) * SHM_V + vst1) = sr_[i].vs1; const int kc = sc * 2; \
    *(LAS bf16x8*)(K_lds + (b) * SHM_K + KSWZ(sr, kc)) = sr_[i].ks0; *(LAS bf16x8*)(K_lds + (b) * SHM_K + KSWZ(32 + sr, kc)) = sr_[i].ks1; } while (0)
#define SWAIT() asm volatile("s_waitcnt vmcnt(4)" ::: "memory")
#define RESC(a) do { if (__any((a) < 1.f)) { if (hi == 0) al_l[r32] = (a); asm volatile("s_waitcnt lgkmcnt(0)" ::: "memory"); \
    _Pragma("unroll") for (int d = 0; d < 4; ++d) _Pragma("unroll") for (int r = 0; r < 16; ++r) o[d][r] *= al_l[crow(r, hi)]; } } while (0)
  f32x16 pA0, pA1, pB0, pB1; float mnA, mnB, alA, alB; bf16x8 pa0, pa1, pa2, pa3; constexpr int NT = NKV / KVBLK;
  constexpr int SE = 0, SO = 1;
  SLOAD(SE, 0); asm volatile("s_waitcnt vmcnt(0)" ::: "memory"); SWRITE(0, SE); __syncthreads();
  qkt(pA0, pA1, K_lds, qr, r32, hi, sub); partialSM(pA0, pA1, m_reg, mnA, alA);
  SLOAD(SO, KVBLK); SLOAD(SE, 2 * KVBLK);
  SWAIT(); SWRITE(1, SO); __syncthreads();
  for (int j = 1; j + 1 < NT; j += 2) {
    SBAR(); qkt(pB0, pB1, K_lds + SHM_K, qr, r32, hi, sub);
    finishSM(pA0, pA1, alA, l_reg, pa0, pa1, pa2, pa3); SBAR();
    SLOAD(SO, (j + 2) * KVBLK); SBAR();
    pv_d0(o, vb0, pa0, pa1, pa2, pa3); partialSM(pB0, pB1, m_reg, mnB, alB);
    __syncthreads(); SWAIT(); SWRITE(0, SE);
    RESC(alB); __syncthreads();
    SBAR(); qkt(pA0, pA1, K_lds, qr, r32, hi, sub);
    finishSM(pB0, pB1, alB, l_reg, pa0, pa1, pa2, pa3); SBAR();
    if (j + 3 < NT) SLOAD(SE, (j + 3) * KVBLK); SBAR();
    pv_d0(o, vb0 + SHM_V, pa0, pa1, pa2, pa3); partialSM(pA0, pA1, m_reg, mnA, alA);
    __syncthreads(); SWAIT(); SWRITE(1, SO);
    RESC(alA); __syncthreads();
  }
  SBAR(); qkt(pB0, pB1, K_lds + SHM_K, qr, r32, hi, sub);
  finishSM(pA0, pA1, alA, l_reg, pa0, pa1, pa2, pa3); SBAR();
  pv_d0(o, vb0, pa0, pa1, pa2, pa3); partialSM(pB0, pB1, m_reg, mnB, alB);
  __syncthreads(); RESC(alB);
  finishSM(pB0, pB1, alB, l_reg, pa0, pa1, pa2, pa3); SBAR();
  pv_d0(o, vb0 + SHM_V, pa0, pa1, pa2, pa3);
  if (hi == 0) li_l[r32] = l_reg; asm volatile("s_waitcnt lgkmcnt(0)" ::: "memory");
  float rli[16];
#pragma unroll
  for (int r = 0; r < 16; ++r) rli[r] = 1.0f / li_l[crow(r, hi)];
  __syncthreads();
  LAS float* xch = (LAS float*)lds + qw * 4096;
  if (sub == 1) {
#pragma unroll
    for (int d0 = 0; d0 < 4; ++d0)
#pragma unroll
      for (int r = 0; r < 16; ++r) xch[(d0 * 16 + r) * 64 + lane] = o[d0][r] * rli[r];
  }
  __syncthreads();
  if (sub == 0) {
    float ssq[16];
#pragma unroll
    for (int r = 0; r < 16; ++r) { float s = 0.f;
#pragma unroll
      for (int d0 = 0; d0 < 4; ++d0) { const float dv = o[d0][r] * rli[r] - lam * xch[(d0 * 16 + r) * 64 + lane]; o[d0][r] = dv; s += dv * dv; }
      ssq[r] = s; }
#pragma unroll
    for (int r = 0; r < 16; ++r) {
#pragma unroll
      for (int off = 1; off < 32; off <<= 1) ssq[r] += __shfl_xor(ssq[r], off);
      ssq[r] = (1.f - LAM_INIT) / sqrtf(ssq[r] * (1.f / 128.f) + EPS); }
    float gg[4];
#pragma unroll
    for (int d0 = 0; d0 < 4; ++d0) gg[d0] = subln_g[d0 * 32 + r32];
    asm volatile("s_waitcnt lgkmcnt(0)" ::: "memory");
#pragma unroll
    for (int r = 0; r < 16; ++r)
#pragma unroll
      for (int d0 = 0; d0 < 4; ++d0) xch[crow(r, hi) * 128 + d0 * 32 + r32] = o[d0][r] * ssq[r] * gg[d0];
    asm volatile("s_waitcnt lgkmcnt(0)" ::: "memory");
    bf16_t* Ow = (bf16_t*)(wsb + WS_AX) + (size_t)(q0 + qw * 32) * AW + h * 128;
#pragma unroll
    for (int it = 0; it < 8; ++it) { const int row = it * 4 + (lane >> 4), ch = lane & 15;
      const f32x4 a = *(const LAS f32x4*)(xch + row * 128 + ch * 8), b = *(const LAS f32x4*)(xch + row * 128 + ch * 8 + 4);
      u32x4 w; w.x = pk2(a.x, a.y); w.y = pk2(a.z, a.w); w.z = pk2(b.x, b.y); w.w = pk2(b.z, b.w);
      *(u32x4*)(Ow + (size_t)row * AW + ch * 8) = w; }
  }
  __syncthreads();
#undef SLOAD
#undef SWRITE
#undef SWAIT
#undef RESC
}
#undef KSWZ
#undef SBAR
}

__device__ __forceinline__ void sgu_unit(const Ctx& C, int chunk, int g, LAS unsigned char* lds) {
    LAS float* vn = (LAS float*)lds; LAS float* stats = (LAS float*)(lds + 65536);
    const int tid = threadIdx.x, lane = tid & 63, w = __builtin_amdgcn_readfirstlane(tid >> 6);
    const bf16_t* VS = (const bf16_t*)(C.ws + WS_VS); const bf16_t* U = (const bf16_t*)(C.ws + WS_U); bf16_t* SX = (bf16_t*)(C.ws + WS_SX);
    for (int t = 0; t < 16; ++t) {
        const int tok = w * 16 + t; const bf16_t* vr = VS + (size_t)(chunk * 128 + tok) * SW; f32x4 v[4]; float s = 0.f;
#pragma unroll
        for (int j = 0; j < 4; ++j) { v[j] = ld_bf16x4(vr + (lane + 64 * j) * 4); s += (v[j].x + v[j].y) + (v[j].z + v[j].w); }
        const float mean = wave_sum(s) * (1.f / SW); float q = 0.f;
#pragma unroll
        for (int j = 0; j < 4; ++j) { const f32x4 d = v[j] - mean; q += (d.x * d.x + d.y * d.y) + (d.z * d.z + d.w * d.w); }
        const float rstd = 1.f / sqrtf(wave_sum(q) * (1.f / SW) + EPS);
        if (lane == 0) { stats[2 * tok] = mean; stats[2 * tok + 1] = rstd; }
    }
    __syncthreads();
#pragma unroll
    for (int k = 0; k < 4; ++k) { const int e8 = tid + 512 * k, j = e8 >> 4, c8 = (e8 & 15) * 8;
        const bf16_t* src = VS + (size_t)(chunk * 128 + j) * SW + g * 128 + c8; const float mean = stats[2 * j], rstd = stats[2 * j + 1];
        const f32x4 a = ld_bf16x4(src), b = ld_bf16x4(src + 4);
        const f32x4 ga = *(const f32x4*)(C.sgu_ln_g + g * 128 + c8), gb = *(const f32x4*)(C.sgu_ln_g + g * 128 + c8 + 4), ba = *(const f32x4*)(C.sgu_ln_b + g * 128 + c8), bb = *(const f32x4*)(C.sgu_ln_b + g * 128 + c8 + 4);
        *(LAS f32x4*)(vn + j * 128 + c8) = (a - mean) * rstd * ga + ba; *(LAS f32x4*)(vn + j * 128 + c8 + 4) = (b - mean) * rstd * gb + bb; }
    __syncthreads();
    for (int ib = 0; ib < 4; ++ib) {
        const int i0 = w * 16 + ib * 4; const float* wr = C.w_spatial + ((size_t)g * 128 + i0) * 128;
        f32x2 acc[4] = {{0.f, 0.f}, {0.f, 0.f}, {0.f, 0.f}, {0.f, 0.f}};
#pragma unroll 8
        for (int j = 0; j < 128; ++j) { const f32x2 v2 = *(const LAS f32x2*)(vn + j * 128 + 2 * lane);
#pragma unroll
            for (int r = 0; r < 4; ++r) acc[r] += v2 * wr[r * 128 + j]; }
#pragma unroll
        for (int r = 0; r < 4; ++r) { const int i = i0 + r; const float bs = C.b_spatial[g * 128 + i]; const size_t oi = (size_t)(chunk * 128 + i) * SW + g * 128 + 2 * lane;
            const unsigned uu = *(const unsigned*)(U + oi);
            *(unsigned*)(SX + oi) = pk2(__uint_as_float(uu << 16) * (acc[r].x + bs), __uint_as_float(uu & 0xffff0000u) * (acc[r].y + bs)); }
    }
    __syncthreads();
}

#define XB_TMO      128
#define XB_XCNT(j)  (256  + 64 * (j))
#define XB_XSUB(j)  (1280 + 64 * (j))
#define XB_XGEN(j)  (2304 + 64 * (j))
#define XB_TOP      3328
#define XB_TOPGEN   3392
#define XCD_BAR_WORDS 3456
#define XB_SPIN_CAP (1u << 22)
__device__ __forceinline__ unsigned xb_ld(unsigned* p)              { return __hip_atomic_load(p, __ATOMIC_RELAXED, __HIP_MEMORY_SCOPE_AGENT); }
__device__ __forceinline__ unsigned xb_add(unsigned* p, unsigned v) { return __hip_atomic_fetch_add(p, v, __ATOMIC_RELAXED, __HIP_MEMORY_SCOPE_AGENT); }
__device__ __forceinline__ unsigned xb_xcc_id() { return (unsigned)__builtin_amdgcn_s_getreg((3 << 11) | 20) & 0xFu; }
#define XB_SPIN(cond, bar) do { unsigned _sp = 0; while (cond) { __builtin_amdgcn_s_sleep(1); \
    if ((++_sp & 255u) == 0u) { if (xb_ld(&(bar)[XB_TMO])) break; if (_sp > XB_SPIN_CAP) { atomicAdd(&(bar)[XB_TMO], 1u); break; } } } } while (0)
struct XcdBarrier { unsigned* bar; unsigned x; volatile LAS unsigned* st; };
__device__ __forceinline__ XcdBarrier xcd_barrier_post(unsigned* bar, volatile LAS unsigned* st) {
    XcdBarrier b; b.bar = bar; b.x = xb_xcc_id(); b.st = st;
    if (threadIdx.x == 0) (void)xb_add(&bar[XB_XCNT(b.x)], 1u);
    return b;
}
__device__ __forceinline__ void xcd_barrier_complete(unsigned* bar, unsigned x, unsigned& nloc, unsigned& nx) {
    const unsigned G = gridDim.x * gridDim.y * gridDim.z;
    unsigned sum, cnt, mine, sp = 0u;
    for (;;) {
        sum = 0u; cnt = 0u; mine = 0u;
#pragma unroll
        for (unsigned j = 0; j < 16; ++j) { const unsigned c = xb_ld(&bar[XB_XCNT(j)]); sum += c; cnt += (c > 0u) ? 1u : 0u; mine = (j == x) ? c : mine; }
        if (sum == G) break;
        __builtin_amdgcn_s_sleep(1);
        if ((++sp & 255u) == 0u) { if (xb_ld(&bar[XB_TMO])) break; if (sp > XB_SPIN_CAP) { atomicAdd(&bar[XB_TMO], 1u); break; } }
    }
    nloc = mine > 0u ? mine : 1u; nx = cnt > 0u ? cnt : 1u;
}
__device__ __forceinline__ void xcd_barrier(const XcdBarrier& b) {
    asm volatile("s_waitcnt vmcnt(0)" ::: "memory");
    __syncthreads();
    if (threadIdx.x == 0) {
        unsigned* bar = b.bar;
        __builtin_amdgcn_s_waitcnt(0);
        unsigned nloc = b.st[0], nx = b.st[1];
        if (nloc == 0u) { xcd_barrier_complete(bar, b.x, nloc, nx); b.st[0] = nloc; b.st[1] = nx; }
        const unsigned old = xb_add(&bar[XB_XSUB(b.x)], 1u);
        const unsigned gen = old / nloc;
        if (old + 1u == (gen + 1u) * nloc) {
            __builtin_amdgcn_fence(__ATOMIC_RELEASE, "agent");
            asm volatile("s_waitcnt vmcnt(0)" ::: "memory");
            const unsigned og = xb_add(&bar[XB_TOP], 1u);
            const unsigned tg = og / nx;
            if (og + 1u == (tg + 1u) * nx) xb_add(&bar[XB_TOPGEN], 1u);
            else XB_SPIN(xb_ld(&bar[XB_TOPGEN]) == tg, bar);
            __builtin_amdgcn_fence(__ATOMIC_ACQUIRE, "agent");
            xb_add(&bar[XB_XGEN(b.x)], 1u);
            asm volatile("s_waitcnt vmcnt(0)" ::: "memory");
        } else {
            XB_SPIN(xb_ld(&bar[XB_XGEN(b.x)]) == gen, bar);
            __builtin_amdgcn_fence(__ATOMIC_ACQUIRE, "agent");
            asm volatile("s_waitcnt vmcnt(0)" ::: "memory");
        }
    }
    __syncthreads();
}

constexpr int LDS_BYTES = 147456, MISC_OFF = 131072 + 320;
constexpr int NPHASE = 10;
__global__ __launch_bounds__(512, 2) void k_mega(Ctx C, int ph_lo, int ph_hi) {
    extern __shared__ __attribute__((aligned(16))) unsigned char lds_raw[];
    LAS unsigned char* lds = (LAS unsigned char*)lds_raw;
    const int tid = threadIdx.x;
    unsigned char* ws = C.ws;
    for (int u = tid; u < (LDS_BYTES - 131072) / 4; u += 512) ((LAS unsigned*)(lds + 131072))[u] = 0u;
    __syncthreads();
    XcdBarrier bar; bar.bar = (unsigned*)(ws + WS_CTL); bar.x = 0; bar.st = nullptr;
    if (ph_hi - ph_lo > 1) bar = xcd_barrier_post((unsigned*)(ws + WS_CTL), (volatile LAS unsigned*)(lds + MISC_OFF));
    const int G = gridDim.x, bx = blockIdx.x;
#define IN(k) (ph_lo <= (k) && (k) < ph_hi)
#define SEAM(k) do { if (IN(k) && IN((k) + 1)) xcd_barrier(bar); } while (0)
    if (IN(0)) { phase0(C, lds); } SEAM(0);
    if (IN(1)) { phase1(C); } SEAM(1);
    if (IN(2)) { pg8::ProjSched S{G, bx, (const char*)(ws + WS_AALL), (const char*)(ws + WS_WIG), (size_t)256 * DM * 2};
        pg8::gemm_phase(lds, DM, S, EpiProj{ws, C.b_gate}); } SEAM(2);
    if (IN(3)) { const float lam = *(const float*)(ws + WS_LAM);
        for (int ui = bx; ui < NH * (SEQ / 128); ui += G) fa::attn_unit(ws, C.subln_g, ui & 7, ui >> 3, lds, lam);
        for (int si = bx; si < (SEQ / CHUNK) * NGRP; si += G) sgu_unit(C, si >> 3, si & 7, lds); } SEAM(3);
    if (IN(4)) { pg8::GridSched S{SEQ / 256, DM / 256, 2, G, bx, (const char*)(ws + WS_AX), (const char*)(ws + WS_SX), (const char*)(ws + WS_WBA), (const char*)(ws + WS_WBS), (size_t)256 * AW * 2};
        pg8::gemm_phase(lds, AW, S, EpiMerge{ws}); } SEAM(4);
    if (IN(5)) { pg8::GridSched S{SEQ / 256, DM / 256, 1, G, bx, (const char*)(ws + WS_T), nullptr, (const char*)(ws + WS_WOUT), nullptr, (size_t)256 * DM * 2};
        pg8::gemm_phase(lds, DM, S, EpiOut{ws, C.x}); } SEAM(5);
    if (IN(6)) { phase_h2(C); } SEAM(6);
    if (IN(7)) { pg8::GridSched S{SEQ / 256, FFD / 256, 1, G, bx, (const char*)(ws + WS_H2), nullptr, (const char*)(ws + WS_WFF1), nullptr, (size_t)256 * DM * 2};
        pg8::gemm_phase(lds, DM, S, EpiFF1{ws}); } SEAM(7);
    if (IN(8)) { pg8::GridSched S{SEQ / 256, DM / 256, 1, G, bx, (const char*)(ws + WS_F), nullptr, (const char*)(ws + WS_WFF2), nullptr, (size_t)256 * FFD * 2};
        pg8::gemm_phase(lds, FFD, S, EpiFF2{ws, C.out}); } SEAM(8);
    if (IN(9)) { phase_final(C); }
#undef IN
#undef SEAM
}

extern "C" void kernel_launch(void* const* d_in, const int* in_sizes, int n_in, void* d_out, int out_size, void* d_ws, size_t ws_size, hipStream_t stream) {
    static int grid = 0;
    if (grid == 0) {
        if (n_in != 26 || in_sizes[0] != SEQ * DM || out_size != SEQ * DM || ws_size < WS_END) {
            fprintf(stderr, "kernel_launch: unexpected shapes n_in %d in0 %d out %d ws %zu (need %zu)\n", n_in, n_in > 0 ? in_sizes[0] : -1, out_size, ws_size, (size_t)WS_END); grid = -1; return; }
        if (hipFuncSetAttribute((const void*)k_mega, hipFuncAttributeMaxDynamicSharedMemorySize, LDS_BYTES) != hipSuccess) { fprintf(stderr, "hipFuncSetAttribute k_mega failed\n"); grid = -1; return; }
        int dev = 0, cus = 0, per_cu = 0;
        if (hipGetDevice(&dev) != hipSuccess || hipDeviceGetAttribute(&cus, hipDeviceAttributeMultiprocessorCount, dev) != hipSuccess) { fprintf(stderr, "device query failed\n"); grid = -1; return; }
        if (hipOccupancyMaxActiveBlocksPerMultiprocessor(&per_cu, (const void*)k_mega, 512, LDS_BYTES) != hipSuccess || per_cu < 1) { fprintf(stderr, "occupancy query failed (%d)\n", per_cu); (void)hipGetLastError(); grid = -1; return; }
        grid = cus * per_cu;
        fprintf(stderr, "kernel_launch: %d CUs x %d workgroups\n", cus, per_cu);
    }
    if (grid < 0) return;
    Ctx C{};
    const float** f = (const float**)&C;
    for (int i = 0; i < 26; ++i) f[i] = (const float*)d_in[i];
    C.out = (float*)d_out; C.ws = (unsigned char*)d_ws;
    (void)hipMemsetAsync((char*)d_ws + WS_CTL, 0, 64 * KiB, stream);
    int lo = 0, hi = NPHASE;
    void* args[] = {(void*)&C, (void*)&lo, (void*)&hi};
    const hipError_t e = hipLaunchCooperativeKernel((const void*)k_mega, dim3(grid), dim3(512), args, LDS_BYTES, stream);
    if (e != hipSuccess) fprintf(stderr, "kernel_launch: cooperative launch failed: %s (grid %d)\n", hipGetErrorString(e), grid);
}
```

```cpp
#include <hip/hip_runtime.h>
#include <cstdio>
#include <cstdint>

#define GAS __attribute__((address_space(1)))
#define LAS __attribute__((address_space(3)))
typedef unsigned short bf16_t;
typedef float f32x4 __attribute__((ext_vector_type(4)));
typedef float f32x2 __attribute__((ext_vector_type(2)));
typedef unsigned u32x4 __attribute__((ext_vector_type(4)));
typedef unsigned u32x2 __attribute__((ext_vector_type(2)));

constexpr int DM = 2048, SEQ = 8192, CTXL = 256, NKV = SEQ + CTXL, AW = 1024, SW = 1024, INW = 5120, GWD = 4096, NPROJ = INW + GWD, FFD = 8192;
constexpr int NH = 8, NSUB = 16, HD = 64, VD = 128, NGRP = 8, CHUNK = 128;
constexpr float EPS = 1e-6f, LAM_INIT = 0.2f;

constexpr size_t MiB = 1u << 20, KiB = 1u << 10;
constexpr size_t WS_CTL = 0, WS_MODX = 64 * KiB, WS_MODC = 112 * KiB, WS_ROPE = 128 * KiB, WS_LAM = 144 * KiB;
constexpr size_t WS_WIG = 1 * MiB, WS_WBA = 37 * MiB, WS_WBS = 41 * MiB, WS_WOUT = 45 * MiB, WS_WFF1 = 53 * MiB, WS_WFF2 = 85 * MiB;
constexpr size_t WS_AALL = 117 * MiB, WS_AX = 117 * MiB, WS_SX = 133 * MiB, WS_H2 = 117 * MiB;
constexpr size_t WS_Q = 150 * MiB, WS_K = 166 * MiB, WS_V = WS_K + (size_t)NKV * AW * 2, WS_U = 199 * MiB, WS_VS = 215 * MiB;
constexpr size_t WS_P = 150 * MiB, WS_X1 = 150 * MiB, WS_G = 231 * MiB, WS_T = 295 * MiB, WS_F = 214 * MiB, WS_OSUB = 295 * MiB;
constexpr size_t WS_END = 360 * MiB;
static_assert(WS_V + (size_t)NKV * AW * 2 <= WS_U, "ws map");

struct Ctx {
    const float *x, *c, *ctx, *c_ctx, *w_ada, *b_ada, *norm1_g, *norm2_g, *w_in, *lam_q1, *lam_k1, *lam_q2, *lam_k2, *subln_g, *sgu_ln_g, *sgu_ln_b,
        *w_spatial, *b_spatial, *w_gate, *b_gate, *w_br_attn, *w_br_sgu, *w_out, *w_ff1, *w_ff2, *final_g;
    float* out; unsigned char* ws;
};

__device__ __forceinline__ float bf2f(bf16_t b) { return __uint_as_float((unsigned)b << 16); }
__device__ __forceinline__ unsigned f2bf(float f) { unsigned u = __float_as_uint(f); return (u + 0x7fffu + ((u >> 16) & 1u)) >> 16; }
__device__ __forceinline__ unsigned pk2(float lo, float hi) { return f2bf(lo) | (f2bf(hi) << 16); }
__device__ __forceinline__ float wave_sum(float v) {
#pragma unroll
    for (int o = 1; o < 64; o <<= 1) v += __shfl_xor(v, o);
    return v;
}
__device__ __forceinline__ float gelu_tanh(float v) {
    const float u = 0.7978845608028654f * (v + 0.044715f * v * v * v);
    return v / (1.f + __expf(-2.f * u));
}
__device__ __forceinline__ float sigmoidf_(float v) { return 1.f / (1.f + __expf(-v)); }

__device__ __forceinline__ void p0_gemv_item(const Ctx& C, int item, LAS float* scr, int tid) {
    const bool isx = item < 192; const int jg = isx ? item : item - 192; const float* vec = isx ? C.c : C.c_ctx;
    float* outp = (float*)(C.ws + (isx ? WS_MODX : WS_MODC));
    for (int k = tid; k < DM; k += 512) { const float v = vec[k]; scr[k] = v / (1.f + expf(-v)); }
    __syncthreads();
    const int lane = tid & 63, w = tid >> 6, cq = lane & 15, rs = w * 4 + (lane >> 4);
    const float* wp = C.w_ada + (size_t)rs * (6 * DM) + jg * 64 + cq * 4;
    f32x4 acc = {0.f, 0.f, 0.f, 0.f};
#pragma unroll 8
    for (int i = 0; i < 64; ++i) { const f32x4 wv = *(const f32x4*)(wp + (size_t)i * 32 * (6 * DM)); acc += wv * scr[rs + 32 * i]; }
    LAS float* red = scr + DM;
    *(LAS f32x4*)(red + rs * 64 + cq * 4) = acc;
    __syncthreads();
    if (tid < 64) { float s = 0.f; for (int r = 0; r < 32; ++r) s += red[r * 64 + tid]; outp[jg * 64 + tid] = s + C.b_ada[jg * 64 + tid]; }
    __syncthreads();
}
__device__ __forceinline__ void p0_transpose_item(const float* W, int K, int N, bf16_t* WT, int row_off, LAS float* scr, int item, int lane) {
    const int nblk = N / 32, kb = item / nblk, nb = item % nblk, k0 = 64 * kb, n0 = 32 * nb;
    float tv[32];
#pragma unroll
    for (int i = 0; i < 32; ++i) tv[i] = W[(size_t)(k0 + 2 * i + (lane >> 5)) * N + n0 + (lane & 31)];
#pragma unroll
    for (int i = 0; i < 32; ++i) scr[(2 * i + (lane >> 5)) * 33 + (lane & 31)] = tv[i];
    asm volatile("s_waitcnt lgkmcnt(0)" ::: "memory");
    const int c = lane & 7;
#pragma unroll
    for (int j = 0; j < 4; ++j) { const int n = (lane >> 3) + 8 * j; const LAS float* s = scr + (8 * c) * 33 + n;
        u32x4 o; o.x = pk2(s[0 * 33], s[1 * 33]); o.y = pk2(s[2 * 33], s[3 * 33]); o.z = pk2(s[4 * 33], s[5 * 33]); o.w = pk2(s[6 * 33], s[7 * 33]);
        *(u32x4*)(WT + (size_t)(row_off + n0 + n) * K + k0 + 8 * c) = o; }
    asm volatile("s_waitcnt lgkmcnt(0)" ::: "memory");
}
__device__ __forceinline__ void p0_small(const Ctx& C, int tid) {
    const double INV[16] = {1.0, 0.5623413251903491, 0.31622776601683794, 0.1778279410038923, 0.1, 0.05623413251903491, 0.03162277660168379, 0.01778279410038923,
                            0.01, 0.005623413251903491, 0.0031622776601683794, 0.0017782794100389228, 0.001, 0.0005623413251903491, 0.00031622776601683794, 0.00017782794100389227};
    f32x2* tab = (f32x2*)(C.ws + WS_ROPE);
    for (int e = tid; e < 128 * 16; e += 512) {
        const int pos = e >> 4, i = e & 15;
        double inv = 0.0;
#pragma unroll
        for (int q = 0; q < 16; ++q) inv = (i == q) ? INV[q] : inv;
        const double a = (double)pos * inv, k = __builtin_rint(a * 0.15915494309189535), r = __builtin_fma(-k, 6.283185307179586, a), r2 = r * r;
        double cs = 1.0, sn = r, tc = 1.0, ts = r;
        for (int n = 1; n <= 14; ++n) { tc = -tc * r2 / (double)((2 * n - 1) * (2 * n)); ts = -ts * r2 / (double)((2 * n) * (2 * n + 1)); cs += tc; sn += ts; }
        tab[e] = (f32x2){(float)cs, (float)sn};
    }
    if (tid == 0) {
        float a = 0.f, b = 0.f;
        for (int i = 0; i < HD; ++i) { a += C.lam_q1[i] * C.lam_k1[i]; b += C.lam_q2[i] * C.lam_k2[i]; }
        *(float*)(C.ws + WS_LAM) = expf(a) - expf(b) + LAM_INIT;
    }
}
constexpr int I_IN = (DM / 64) * (INW / 32), I_G = (DM / 64) * (GWD / 32), I_BA = (AW / 64) * (DM / 32), I_O = (DM / 64) * (DM / 32), I_1 = (DM / 64) * (FFD / 32), I_2 = (FFD / 64) * (DM / 32);
constexpr int T_EARLY = I_IN + I_G, T_ALL = T_EARLY + 2 * I_BA + I_O + I_1 + I_2;
__device__ __forceinline__ void transpose_items(const Ctx& C, LAS unsigned char* lds, int first, int last, int gw, int NGW) {
    const int lane = threadIdx.x & 63, wave = threadIdx.x >> 6;
    LAS float* scr = (LAS float*)(lds + wave * 16384);
    for (int it = first + gw; it < last; it += NGW) {
        int r = it;
        if (r < I_IN) { p0_transpose_item(C.w_in, DM, INW, (bf16_t*)(C.ws + WS_WIG), 0, scr, r, lane); continue; } r -= I_IN;
        if (r < I_G) { p0_transpose_item(C.w_gate, DM, GWD, (bf16_t*)(C.ws + WS_WIG), INW, scr, r, lane); continue; } r -= I_G;
        if (r < I_BA) { p0_transpose_item(C.w_br_attn, AW, DM, (bf16_t*)(C.ws + WS_WBA), 0, scr, r, lane); continue; } r -= I_BA;
        if (r < I_BA) { p0_transpose_item(C.w_br_sgu, SW, DM, (bf16_t*)(C.ws + WS_WBS), 0, scr, r, lane); continue; } r -= I_BA;
        if (r < I_O) { p0_transpose_item(C.w_out, DM, DM, (bf16_t*)(C.ws + WS_WOUT), 0, scr, r, lane); continue; } r -= I_O;
        if (r < I_1) { p0_transpose_item(C.w_ff1, DM, FFD, (bf16_t*)(C.ws + WS_WFF1), 0, scr, r, lane); continue; } r -= I_1;
        p0_transpose_item(C.w_ff2, FFD, DM, (bf16_t*)(C.ws + WS_WFF2), 0, scr, r, lane);
    }
}
__device__ __forceinline__ void phase0(const Ctx& C, LAS unsigned char* lds) {
    const int tid = threadIdx.x, G = gridDim.x, b = blockIdx.x;
    for (int it = b; it < 256; it += G) p0_gemv_item(C, it, (LAS float*)lds, tid);
    if (b == G - 1) p0_small(C, tid);
    transpose_items(C, lds, 0, T_EARLY, b * 8 + (tid >> 6), G * 8);
}
__device__ __forceinline__ void phase2_tail(const Ctx& C, LAS unsigned char* lds) {
    constexpr int NU = 32 * 36 + 8;
    const int G = gridDim.x, b = blockIdx.x, nmax = (NU + G - 1) / G, first_idle = NU - (nmax - 1) * G, n_idle = G - first_idle;
    if (n_idle >= 32) { if (b >= first_idle) transpose_items(C, lds, T_EARLY, T_ALL, (b - first_idle) * 8 + (threadIdx.x >> 6), n_idle * 8); }
    else transpose_items(C, lds, T_EARLY, T_ALL, b * 8 + (threadIdx.x >> 6), G * 8);
}

__device__ __forceinline__ void modnorm_row(const float* xrow, const float* g, const float* scale, const float* shift, bf16_t* orow, int lane) {
    f32x4 v[8]; float s = 0.f;
#pragma unroll
    for (int j = 0; j < 8; ++j) { v[j] = *(const f32x4*)(xrow + (lane + 64 * j) * 4); s += (v[j].x * v[j].x + v[j].y * v[j].y) + (v[j].z * v[j].z + v[j].w * v[j].w); }
    const float rinv = 1.0f / sqrtf(wave_sum(s) * (1.f / DM) + EPS);
#pragma unroll
    for (int j = 0; j < 8; ++j) {
        const int c = (lane + 64 * j) * 4;
        const f32x4 gv = *(const f32x4*)(g + c), sc = *(const f32x4*)(scale + c), sh = *(const f32x4*)(shift + c);
        const f32x4 o = (v[j] * rinv) * gv * (sc + 1.0f) + sh;
        u32x2 w; w.x = pk2(o.x, o.y); w.y = pk2(o.z, o.w);
        *(u32x2*)(orow + c) = w;
    }
}
__device__ __forceinline__ void phase1(const Ctx& C) {
    const int lane = threadIdx.x & 63, gw = blockIdx.x * 8 + (threadIdx.x >> 6), NGW = gridDim.x * 8;
    const float* modx = (const float*)(C.ws + WS_MODX); const float* modc = (const float*)(C.ws + WS_MODC);
    bf16_t* A = (bf16_t*)(C.ws + WS_AALL);
    for (int r = gw; r < NKV; r += NGW) {
        if (r < CTXL) modnorm_row(C.ctx + (size_t)r * DM, C.norm1_g, modc + DM, modc, A + (size_t)r * DM, lane);
        else modnorm_row(C.x + (size_t)(r - CTXL) * DM, C.norm1_g, modx + DM, modx, A + (size_t)r * DM, lane);
    }
}
__device__ __forceinline__ void phase_h2(const Ctx& C) {
    const int lane = threadIdx.x & 63, gw = blockIdx.x * 8 + (threadIdx.x >> 6), NGW = gridDim.x * 8;
    const float* modx = (const float*)(C.ws + WS_MODX);
    const float* X1 = (const float*)(C.ws + WS_X1); bf16_t* H2 = (bf16_t*)(C.ws + WS_H2);
    for (int r = gw; r < SEQ; r += NGW) modnorm_row(X1 + (size_t)r * DM, C.norm2_g, modx + 4 * DM, modx + 3 * DM, H2 + (size_t)r * DM, lane);
}
__device__ __forceinline__ void phase_final(const Ctx& C) {
    const int lane = threadIdx.x & 63, gw = blockIdx.x * 8 + (threadIdx.x >> 6), NGW = gridDim.x * 8;
    for (int r = gw; r < SEQ; r += NGW) {
        float* xrow = C.out + (size_t)r * DM;
        f32x4 v[8]; float s = 0.f;
#pragma unroll
        for (int j = 0; j < 8; ++j) { v[j] = *(const f32x4*)(xrow + (lane + 64 * j) * 4); s += (v[j].x * v[j].x + v[j].y * v[j].y) + (v[j].z * v[j].z + v[j].w * v[j].w); }
        const float rinv = 1.0f / sqrtf(wave_sum(s) * (1.f / DM) + EPS);
#pragma unroll
        for (int j = 0; j < 8; ++j) { const int c = (lane + 64 * j) * 4; *(f32x4*)(xrow + c) = (v[j] * rinv) * *(const f32x4*)(C.final_g + c); }
    }
}

namespace pg8 {
typedef short bf16x8 __attribute__((ext_vector_type(8)));
constexpr int BM = 256, BK = 64, HALF = 128, HTB = HALF * BK * 2  , STAGE_BYTES = 8 * HTB, NXCD = 8, WGM = 8;
__device__ __forceinline__ int lds_byte(int r, int c) { const int st = (r >> 4) * 2 + (c >> 5), rr = r & 15, cc = c & 31, ob = rr * 64 + cc * 2; return st * 1024 + (ob ^ (((ob >> 9) & 1) << 5)); }
__device__ __forceinline__ void stage_rc(int b, int& R, int& C) { const int st = b / 1024, sb = b % 1024, swz = sb ^ (((sb >> 9) & 1) << 5); R = (st >> 1) * 16 + swz / 64; C = (st & 1) * 32 + (swz % 64) / 2; }
__device__ __forceinline__ int perm32(int rho) { const int n = rho >> 4, i = rho & 15; return 8 * (i >> 2) + 4 * n + (i & 3); }

struct Unit { int pm, pn, z; };

struct GridSched {
    int nM, nN, nz, G, c; const char *A0, *A1, *B0, *B1; size_t tstep;
    __device__ __forceinline__ bool next(int i, Unit& u) const {
        const int ti = i / nz; u.z = i - ti * nz;
        const int nwg = nM * nN; const long L = (long)ti * G + c; if (L >= nwg) return false;
        int wgid = (int)L; { const int q = nwg / NXCD, r = nwg % NXCD, xcd = wgid % NXCD, off = wgid / NXCD; wgid = (xcd < r ? xcd * (q + 1) : r * (q + 1) + (xcd - r) * q) + off; }
        const int nig = WGM * nN, gid = wgid / nig, fm = gid * WGM, gsz = (nM - fm) < WGM ? (nM - fm) : WGM;
        u.pm = fm + ((wgid % nig) % gsz); u.pn = (wgid % nig) / gsz; return true;
    }
    __device__ __forceinline__ const char* aptr(const Unit& u) const { return (u.z ? A1 : A0) + (size_t)u.pm * tstep; }
    __device__ __forceinline__ const char* bptr(const Unit& u) const { return (u.z ? B1 : B0) + (size_t)u.pn * tstep; }
};
struct ProjSched {
    int G, c; const char *A, *B; size_t tstep;
    __device__ __forceinline__ bool next(int i, Unit& u) const {
        constexpr int NW = 32 * 36 + 8;
        const long L = (long)i * G + c; if (L >= NW) return false;
        const int wgid = (int)(L % NXCD) * (NW / NXCD) + (int)(L / NXCD); u.z = 0;
        if (wgid >= 32 * 36) { u.pm = 0; u.pn = 4 + (wgid - 32 * 36); }
        else { const int nig = WGM * 36, gid = wgid / nig, r = wgid % nig; u.pm = 1 + gid * WGM + (r % WGM); u.pn = r / WGM; }
        return true;
    }
    __device__ __forceinline__ const char* aptr(const Unit& u) const { return A + (size_t)u.pm * tstep; }
    __device__ __forceinline__ const char* bptr(const Unit& u) const { return B + (size_t)u.pn * tstep; }
};

template <class Epi> __device__ __forceinline__ void run_epi(const Epi& E, const f32x4 (&acc)[2][2][4][2], const Unit& u, int wr, int wc, int fr, int fq) {
    const int row0 = u.pm * BM + wr * 64 + fr, col0 = u.pn * BM + wc * 32 + 8 * fq;
#pragma unroll
    for (int ai = 0; ai < 2; ++ai)
#pragma unroll
        for (int m = 0; m < 4; ++m)
#pragma unroll
            for (int bj = 0; bj < 2; ++bj)
#pragma unroll
                for (int n = 0; n < 2; ++n) E(u, row0 + ai * HALF + m * 16, col0 + bj * HALF + 4 * n, acc[ai][bj][m][n]);
}

template <class Epi, class Sched>
__device__ __forceinline__ void gemm_phase(LAS unsigned char* lds, const int K, const Sched& S, const Epi& E) {
    const int tid = threadIdx.x, wid = __builtin_amdgcn_readfirstlane(tid >> 6), lane = tid & 63, wr = wid >> 2, wc = wid & 3, fr = lane & 15, fq = lane >> 4;
    const int nt = K / BK;
    unsigned voffA[2], voffB[2];
#pragma unroll
    for (int i = 0; i < 2; ++i) { int R, C; stage_rc(tid * 16 + i * 8192, R, C); const int Rb = (R & ~31) + perm32(R & 31);
        voffA[i] = (unsigned)(R * K + C) * 2u; voffB[i] = (unsigned)(Rb * K + C) * 2u; }
    const size_t kstep = (size_t)(BK * 2);
    const size_t hstep = (size_t)HALF * K * 2;
    const unsigned ldsw = (unsigned)wid * 1024u;
    const int aoff = lds_byte(wr * 64 + fr, fq * 8), boff = lds_byte(wc * 32 + fr, fq * 8);
#define PG8_SA(b, h) (((b) * 2 + (h)) * HTB)
#define PG8_SB(b, h) ((4 + (b) * 2 + (h)) * HTB)
#define PG8_STAGE(bufoff, gbase, voff) do { _Pragma("unroll") for (int _i = 0; _i < 2; ++_i) \
        __builtin_amdgcn_global_load_lds((const unsigned*)((const char*)(gbase) + (voff)[_i]), (LAS unsigned*)(lds + (bufoff) + ldsw + _i * 8192), 16, 0, 0); } while (0)
#define PG8_LDA(dst, b, h) do { _Pragma("unroll") for (int m = 0; m < 4; ++m) _Pragma("unroll") for (int k = 0; k < 2; ++k) dst[m][k] = *(const LAS bf16x8*)(lds + PG8_SA(b, h) + aoff + m * 2048 + k * 1024); } while (0)
#define PG8_LDB(dst, b, h) do { _Pragma("unroll") for (int n = 0; n < 2; ++n) _Pragma("unroll") for (int k = 0; k < 2; ++k) dst[n][k] = *(const LAS bf16x8*)(lds + PG8_SB(b, h) + boff + n * 2048 + k * 1024); } while (0)
#define PG8_MMA(ai, bj, At, Bt) do { __builtin_amdgcn_s_setprio(1); _Pragma("unroll") for (int m = 0; m < 4; ++m) _Pragma("unroll") for (int n = 0; n < 2; ++n) _Pragma("unroll") for (int k = 0; k < 2; ++k) \
        acc[ai][bj][m][n] = __builtin_amdgcn_mfma_f32_16x16x32_bf16(Bt[n][k], At[m][k], acc[ai][bj][m][n], 0, 0, 0); __builtin_amdgcn_s_setprio(0); } while (0)
#define PG8_WAIT_V(n) asm volatile("s_waitcnt vmcnt(" #n ")" ::: "memory")
#define PG8_WAIT_L(n) asm volatile("s_waitcnt lgkmcnt(" #n ")" ::: "memory")
#define PG8_BAR __builtin_amdgcn_s_barrier()
#define PG8_SCHED __builtin_amdgcn_sched_barrier(0)
    Unit cur, nxt; int ui = 0;
    if (!S.next(0, cur)) return;
    f32x4 acc[2][2][4][2];
#pragma unroll
    for (int a = 0; a < 2; ++a)
#pragma unroll
        for (int b = 0; b < 2; ++b)
#pragma unroll
            for (int m = 0; m < 4; ++m)
#pragma unroll
                for (int n = 0; n < 2; ++n) acc[a][b][m][n] = (f32x4){0.f, 0.f, 0.f, 0.f};
    bf16x8 At[4][2], B0[2][2], B1[2][2];
    const char* cA = S.aptr(cur); const char* cB = S.bptr(cur);
    PG8_STAGE(PG8_SB(0, 0), cB, voffB); PG8_STAGE(PG8_SB(0, 1), cB + hstep, voffB); PG8_STAGE(PG8_SA(0, 0), cA, voffA); PG8_STAGE(PG8_SA(0, 1), cA + hstep, voffA);
    if (wr == 1) PG8_BAR;
    PG8_WAIT_V(2); PG8_BAR;
    PG8_STAGE(PG8_SB(1, 0), cB + kstep, voffB); PG8_STAGE(PG8_SA(1, 0), cA + kstep, voffA); PG8_STAGE(PG8_SB(1, 1), cB + hstep + kstep, voffB);
    PG8_WAIT_V(6); PG8_BAR;
    for (;;) {
        const bool has_next = S.next(ui + 1, nxt);
        const char* nA = has_next ? S.aptr(nxt) : cA; const char* nB = has_next ? S.bptr(nxt) : cB;
        for (int t = 0; t < nt; t += 2) {
            const bool last = (t == nt - 2);
            const char* a1 = cA + (size_t)(t + 1) * kstep;
            const char* a2 = last ? nA : cA + (size_t)(t + 2) * kstep; const char* b2 = last ? nB : cB + (size_t)(t + 2) * kstep;
            const char* a3 = a2 + kstep; const char* b3 = b2 + kstep;
            PG8_LDB(B0, 0, 0); PG8_LDB(B1, 0, 1); PG8_SCHED; PG8_LDA(At, 0, 0); PG8_STAGE(PG8_SA(1, 1), a1 + hstep, voffA);
            PG8_WAIT_V(8); PG8_WAIT_L(0); PG8_BAR; PG8_MMA(0, 0, At, B0); PG8_MMA(0, 1, At, B1); PG8_BAR; PG8_SCHED;
            PG8_LDA(At, 0, 1); PG8_STAGE(PG8_SB(0, 0), b2, voffB); PG8_STAGE(PG8_SB(0, 1), b2 + hstep, voffB); PG8_STAGE(PG8_SA(0, 0), a2, voffA);
            PG8_WAIT_V(8); PG8_WAIT_L(0); PG8_BAR; PG8_MMA(1, 0, At, B0); PG8_MMA(1, 1, At, B1); PG8_BAR; PG8_SCHED;
            PG8_LDB(B0, 1, 0); PG8_LDB(B1, 1, 1); PG8_SCHED; PG8_LDA(At, 1, 0); PG8_STAGE(PG8_SA(0, 1), a2 + hstep, voffA);
            PG8_WAIT_V(8); PG8_WAIT_L(0); PG8_BAR; PG8_MMA(0, 0, At, B0); PG8_MMA(0, 1, At, B1); PG8_BAR; PG8_SCHED;
            PG8_LDA(At, 1, 1); PG8_STAGE(PG8_SB(1, 0), b3, voffB); PG8_STAGE(PG8_SB(1, 1), b3 + hstep, voffB); PG8_STAGE(PG8_SA(1, 0), a3, voffA);
            PG8_WAIT_V(8); PG8_WAIT_L(0); PG8_BAR; PG8_MMA(1, 0, At, B0); PG8_MMA(1, 1, At, B1); PG8_BAR; PG8_SCHED;
        }
        if (wr == 0) PG8_BAR;
        run_epi(E, acc, cur, wr, wc, fr, fq);
        if (!has_next) break;
#pragma unroll
        for (int a = 0; a < 2; ++a)
#pragma unroll
            for (int b = 0; b < 2; ++b)
#pragma unroll
                for (int m = 0; m < 4; ++m)
#pragma unroll
                    for (int n = 0; n < 2; ++n) acc[a][b][m][n] = (f32x4){0.f, 0.f, 0.f, 0.f};
        cur = nxt; cA = nA; cB = nB; ++ui;
        if (wr == 1) PG8_BAR;
    }
    PG8_WAIT_V(0);
    PG8_BAR;
#undef PG8_SA
#undef PG8_SB
#undef PG8_STAGE
#undef PG8_LDA
#undef PG8_LDB
#undef PG8_MMA
#undef PG8_WAIT_V
#undef PG8_WAIT_L
#undef PG8_BAR
#undef PG8_SCHED
}
}

__device__ __forceinline__ void st_bf16x4(bf16_t* p, f32x4 o) { u32x2 w; w.x = pk2(o.x, o.y); w.y = pk2(o.z, o.w); *(u32x2*)p = w; }
struct EpiProj {
    unsigned char* ws; const float* b_gate;
    __device__ __forceinline__ f32x4 rope(f32x4 v, int n, int c) const {
        const int cih = c & 63, p0 = cih >> 1, pos = (p0 < 16) ? (n >> 6) : (n & 63), i0 = p0 & 15;
        const f32x4 t = *(const f32x4*)((const float*)(ws + WS_ROPE) + (pos * 16 + i0) * 2);
        return (f32x4){v.x * t.x - v.y * t.y, v.x * t.y + v.y * t.x, v.z * t.z - v.w * t.w, v.z * t.w + v.w * t.z};
    }
    __device__ __forceinline__ void operator()(const pg8::Unit& u, int row, int col, f32x4 v) const {
        const int n = row - CTXL;
        if (col < AW) { st_bf16x4((bf16_t*)(ws + WS_Q) + (size_t)n * AW + col, rope(v, n, col)); }
        else if (col < 2 * AW) { const int c = col - AW; st_bf16x4((bf16_t*)(ws + WS_K) + (size_t)row * AW + c, n >= 0 ? rope(v, n, c) : v); }
        else if (col < 3 * AW) { st_bf16x4((bf16_t*)(ws + WS_V) + (size_t)row * AW + (col - 2 * AW), v); }
        else if (col < 3 * AW + SW) { st_bf16x4((bf16_t*)(ws + WS_U) + (size_t)n * SW + (col - 3 * AW), (f32x4){gelu_tanh(v.x), gelu_tanh(v.y), gelu_tanh(v.z), gelu_tanh(v.w)}); }
        else if (col < INW) { st_bf16x4((bf16_t*)(ws + WS_VS) + (size_t)n * SW + (col - 3 * AW - SW), (f32x4){gelu_tanh(v.x), gelu_tanh(v.y), gelu_tanh(v.z), gelu_tanh(v.w)}); }
        else { const int c = col - INW; const f32x4 b = *(const f32x4*)(b_gate + c);
            st_bf16x4((bf16_t*)(ws + WS_G) + (size_t)n * GWD + c, (f32x4){sigmoidf_(v.x + b.x), sigmoidf_(v.y + b.y), sigmoidf_(v.z + b.z), sigmoidf_(v.w + b.w)}); }
    }
};
__device__ __forceinline__ f32x4 ld_bf16x4(const bf16_t* p) { const u32x2 w = *(const u32x2*)p; return (f32x4){__uint_as_float(w.x << 16), __uint_as_float(w.x & 0xffff0000u), __uint_as_float(w.y << 16), __uint_as_float(w.y & 0xffff0000u)}; }
struct EpiMerge { unsigned char* ws;
    __device__ __forceinline__ void operator()(const pg8::Unit& u, int row, int col, f32x4 v) const {
        float* pp = (float*)(ws + WS_P) + (size_t)row * DM + col;
        if (u.z == 0) { const f32x4 g = ld_bf16x4((const bf16_t*)(ws + WS_G) + (size_t)row * GWD + col); *(f32x4*)pp = g * v; }
        else { const f32x4 g = ld_bf16x4((const bf16_t*)(ws + WS_G) + (size_t)row * GWD + DM + col); const f32x4 p = *(const f32x4*)pp;
            st_bf16x4((bf16_t*)(ws + WS_T) + (size_t)row * DM + col, p + g * v); } } };
struct EpiOut { unsigned char* ws; const float* x;
    __device__ __forceinline__ void operator()(const pg8::Unit& u, int row, int col, f32x4 v) const {
        const f32x4 g = *(const f32x4*)((const float*)(ws + WS_MODX) + 2 * DM + col);
        *(f32x4*)((float*)(ws + WS_X1) + (size_t)row * DM + col) = *(const f32x4*)(x + (size_t)row * DM + col) + g * v; } };
struct EpiFF1 { unsigned char* ws;
    __device__ __forceinline__ void operator()(const pg8::Unit& u, int row, int col, f32x4 v) const {
        const f32x4 r = {fmaxf(v.x, 0.f), fmaxf(v.y, 0.f), fmaxf(v.z, 0.f), fmaxf(v.w, 0.f)};
        st_bf16x4((bf16_t*)(ws + WS_F) + (size_t)row * FFD + col, r * r); } };
struct EpiFF2 { unsigned char* ws; float* out;
    __device__ __forceinline__ void operator()(const pg8::Unit& u, int row, int col, f32x4 v) const {
        const f32x4 g = *(const f32x4*)((const float*)(ws + WS_MODX) + 5 * DM + col);
        *(f32x4*)(out + (size_t)row * DM + col) = *(const f32x4*)((const float*)(ws + WS_X1) + (size_t)row * DM + col) + g * v; } };

__global__ __launch_bounds__(256) void naive_attn(Ctx C) {
    __shared__ float Ks[16][64], Vs[16][128];
    const int tid = threadIdx.x, sub = blockIdx.y, h = sub >> 1, row = blockIdx.x * 256 + tid;
    const bf16_t* Q = (const bf16_t*)(C.ws + WS_Q); const bf16_t* Kb = (const bf16_t*)(C.ws + WS_K); const bf16_t* Vb = (const bf16_t*)(C.ws + WS_V);
    float q[64], o[128];
#pragma unroll
    for (int d = 0; d < 64; d += 4) { const f32x4 t = ld_bf16x4(Q + (size_t)row * AW + sub * 64 + d); q[d] = t.x * 0.125f; q[d + 1] = t.y * 0.125f; q[d + 2] = t.z * 0.125f; q[d + 3] = t.w * 0.125f; }
#pragma unroll
    for (int d = 0; d < 128; ++d) o[d] = 0.f;
    float m = -1e30f, l = 0.f;
    for (int k0 = 0; k0 < NKV; k0 += 16) {
        __syncthreads();
        { const int kr = tid >> 4, kc = (tid & 15) * 4; const f32x4 t = ld_bf16x4(Kb + (size_t)(k0 + kr) * AW + sub * 64 + kc); *(f32x4*)&Ks[kr][kc] = t; }
        { const int vr = tid >> 4, vc = (tid & 15) * 8; const f32x4 t0 = ld_bf16x4(Vb + (size_t)(k0 + vr) * AW + h * 128 + vc), t1 = ld_bf16x4(Vb + (size_t)(k0 + vr) * AW + h * 128 + vc + 4);
          *(f32x4*)&Vs[vr][vc] = t0; *(f32x4*)&Vs[vr][vc + 4] = t1; }
        __syncthreads();
        float s[16]; float tm = -1e30f;
#pragma unroll
        for (int j = 0; j < 16; ++j) { float a = 0.f;
#pragma unroll
            for (int d = 0; d < 64; d += 4) { const f32x4 kv = *(const f32x4*)&Ks[j][d]; a += q[d] * kv.x + q[d + 1] * kv.y + q[d + 2] * kv.z + q[d + 3] * kv.w; }
            s[j] = a; tm = fmaxf(tm, a); }
        const float mn = fmaxf(m, tm), alpha = expf(m - mn); m = mn; l *= alpha;
#pragma unroll
        for (int d = 0; d < 128; ++d) o[d] *= alpha;
#pragma unroll
        for (int j = 0; j < 16; ++j) { const float p = expf(s[j] - mn); l += p;
#pragma unroll
            for (int d = 0; d < 128; d += 4) { const f32x4 vv = *(const f32x4*)&Vs[j][d]; o[d] += p * vv.x; o[d + 1] += p * vv.y; o[d + 2] += p * vv.z; o[d + 3] += p * vv.w; } }
    }
    const float rl = 1.f / l; float* O = (float*)(C.ws + WS_OSUB) + ((size_t)sub * SEQ + row) * 128;
#pragma unroll
    for (int d = 0; d < 128; d += 4) *(f32x4*)(O + d) = (f32x4){o[d] * rl, o[d + 1] * rl, o[d + 2] * rl, o[d + 3] * rl};
}
__global__ __launch_bounds__(256) void naive_attn_combine(Ctx C) {
    const int lane = threadIdx.x & 63, gw = blockIdx.x * 4 + (threadIdx.x >> 6);
    const int row = gw >> 3, h = gw & 7; if (row >= SEQ) return;
    const float lam = *(const float*)(C.ws + WS_LAM);
    const float* O1 = (const float*)(C.ws + WS_OSUB) + ((size_t)(2 * h) * SEQ + row) * 128; const float* O2 = (const float*)(C.ws + WS_OSUB) + ((size_t)(2 * h + 1) * SEQ + row) * 128;
    const float a = O1[lane * 2] - lam * O2[lane * 2], b = O1[lane * 2 + 1] - lam * O2[lane * 2 + 1];
    const float rinv = 1.f / sqrtf(wave_sum(a * a + b * b) * (1.f / 128.f) + EPS);
    const float ga = C.subln_g[lane * 2], gb = C.subln_g[lane * 2 + 1];
    *(unsigned*)((bf16_t*)(C.ws + WS_AX) + (size_t)row * AW + h * 128 + lane * 2) = pk2(a * rinv * ga * (1.f - LAM_INIT), b * rinv * gb * (1.f - LAM_INIT));
}
__global__ __launch_bounds__(256) void naive_sgu(Ctx C) {
    extern __shared__ float sm[];
    float* vn = sm; float* stats = sm + 128 * 128;
    const int tid = threadIdx.x, lane = tid & 63, w = tid >> 6, chunk = blockIdx.x >> 3, g = blockIdx.x & 7;
    const bf16_t* VS = (const bf16_t*)(C.ws + WS_VS); const bf16_t* U = (const bf16_t*)(C.ws + WS_U);
    for (int t = w; t < 128; t += 4) {
        const bf16_t* vr = VS + (size_t)(chunk * 128 + t) * SW; float v[16]; float s = 0.f;
#pragma unroll
        for (int j = 0; j < 4; ++j) { const f32x4 a = ld_bf16x4(vr + (lane + 64 * j) * 4); v[4 * j] = a.x; v[4 * j + 1] = a.y; v[4 * j + 2] = a.z; v[4 * j + 3] = a.w; s += (a.x + a.y) + (a.z + a.w); }
        const float mean = wave_sum(s) * (1.f / SW); float q = 0.f;
#pragma unroll
        for (int j = 0; j < 16; ++j) { const float d = v[j] - mean; q += d * d; }
        const float rstd = 1.f / sqrtf(wave_sum(q) * (1.f / SW) + EPS);
        if (lane == 0) { stats[2 * t] = mean; stats[2 * t + 1] = rstd; }
    }
    __syncthreads();
    for (int e = tid; e < 128 * 128; e += 256) { const int j = e >> 7, c = e & 127;
        vn[e] = (bf2f(VS[(size_t)(chunk * 128 + j) * SW + g * 128 + c]) - stats[2 * j]) * stats[2 * j + 1] * C.sgu_ln_g[g * 128 + c] + C.sgu_ln_b[g * 128 + c]; }
    __syncthreads();
    const int c = tid & 127, ih = tid >> 7;
    for (int i = ih * 64; i < ih * 64 + 64; ++i) {
        const float* wr = C.w_spatial + ((size_t)g * 128 + i) * 128; float a = 0.f;
        for (int j = 0; j < 128; ++j) a += wr[j] * vn[j * 128 + c];
        a += C.b_spatial[g * 128 + i];
        const size_t oi = (size_t)(chunk * 128 + i) * SW + g * 128 + c;
        ((bf16_t*)(C.ws + WS_SX))[oi] = (bf16_t)f2bf(bf2f(U[oi]) * a);
    }
}

namespace fa {
typedef short bf16x8 __attribute__((ext_vector_type(8)));
typedef short s16x4 __attribute__((ext_vector_type(4)));
typedef float f32x16 __attribute__((ext_vector_type(16)));
constexpr int KVBLK = 64, SHM_V = KVBLK * 128 * 2, SHM_K = KVBLK * 128 * 2, LDK = AW;
constexpr float SCALE = 0.125f, THR = 8.f;
#define KSWZ(row, colB) ((row) * 256 + ((colB) ^ (((row) & 7) << 4)))
#define SBAR() __builtin_amdgcn_sched_barrier(0)
__device__ __forceinline__ int crow(int r, int hi) { return (r & 3) + 8 * (r >> 2) + 4 * hi; }
__device__ __forceinline__ unsigned cvtpk(float lo, float hi) { unsigned r; asm volatile("v_cvt_pk_bf16_f32 %0, %1, %2" : "=v"(r) : "v"(lo), "v"(hi)); return r; }
__device__ __forceinline__ void partialSM(f32x16& p0, f32x16& p1, float& m_reg, float& mn, float& alpha) {
  constexpr float Cc = SCALE * 1.4426950408889634f;
  float pmax = p0[0];
#pragma unroll
  for (int r = 1; r < 16; ++r) pmax = fmaxf(pmax, p0[r]);
#pragma unroll
  for (int r = 0; r < 16; ++r) pmax = fmaxf(pmax, p1[r]);
  { auto rr = __builtin_amdgcn_permlane32_swap(__float_as_uint(pmax), __float_as_uint(pmax), false, false);
    pmax = fmaxf(__uint_as_float(rr[0]), __uint_as_float(rr[1])); }
  if (__builtin_expect(__all(pmax - m_reg <= THR / SCALE), 1)) { mn = m_reg; alpha = 1.f; }
  else { mn = fmaxf(m_reg, pmax); alpha = __builtin_amdgcn_exp2f((m_reg - mn) * Cc); m_reg = mn; }
  const float mnC = -mn * Cc;
#pragma unroll
  for (int r = 0; r < 16; ++r) p0[r] = fmaf(p0[r], Cc, mnC);
#pragma unroll
  for (int r = 0; r < 16; ++r) p1[r] = fmaf(p1[r], Cc, mnC);
#pragma unroll
  for (int r = 0; r < 16; ++r) p0[r] = __builtin_amdgcn_exp2f(p0[r]);
}
__device__ __forceinline__ void finishSM(f32x16& p0, f32x16& p1, float alpha, float& l_reg, bf16x8& pa0, bf16x8& pa1, bf16x8& pa2, bf16x8& pa3) {
#pragma unroll
  for (int r = 0; r < 16; ++r) p1[r] = __builtin_amdgcn_exp2f(p1[r]);
  float ps = 0;
#pragma unroll
  for (int r = 0; r < 16; ++r) ps += p0[r];
#pragma unroll
  for (int r = 0; r < 16; ++r) ps += p1[r];
  { auto rr = __builtin_amdgcn_permlane32_swap(__float_as_uint(ps), __float_as_uint(ps), false, false);
    ps = __uint_as_float(rr[0]) + __uint_as_float(rr[1]); }
  l_reg = l_reg * alpha + ps;
#define PK4(P, BASE, OUT) do { unsigned a0 = cvtpk(P[BASE + 0], P[BASE + 1]), a1 = cvtpk(P[BASE + 2], P[BASE + 3]);   \
    unsigned b0 = cvtpk(P[BASE + 4], P[BASE + 5]), b1 = cvtpk(P[BASE + 6], P[BASE + 7]);                              \
    auto r0 = __builtin_amdgcn_permlane32_swap(a0, b0, false, false); auto r1 = __builtin_amdgcn_permlane32_swap(a1, b1, false, false); \
    u32x4 w = {r0[0], r1[0], r0[1], r1[1]}; OUT = __builtin_bit_cast(bf16x8, w); } while (0)
  PK4(p0, 0, pa0); PK4(p0, 8, pa1); PK4(p1, 0, pa2); PK4(p1, 8, pa3);
#undef PK4
}
__device__ __forceinline__ void qkt(f32x16& p0, f32x16& p1, const LAS unsigned char* Ks, const bf16x8* qr, int r32, int hi, int sub) {
  p0 = f32x16{}; p1 = f32x16{};
#pragma unroll
  for (int d0 = 0; d0 < 4; ++d0) { const int cb = (sub * 64 + d0 * 16 + hi * 8) * 2;
    const bf16x8 b0 = *(const LAS bf16x8*)(Ks + KSWZ(r32, cb));
    const bf16x8 b1 = *(const LAS bf16x8*)(Ks + KSWZ(32 + r32, cb));
    p0 = __builtin_amdgcn_mfma_f32_32x32x16_bf16(b0, qr[d0], p0, 0, 0, 0);
    p1 = __builtin_amdgcn_mfma_f32_32x32x16_bf16(b1, qr[d0], p1, 0, 0, 0); }
}
__device__ __forceinline__ int v_st(int k, int c) { const int kk = (k & ~0xC) | ((k & 4) << 1) | ((k & 8) >> 1); return ((kk >> 3) * 4 + (c >> 5)) * 512 + ((kk & 7) * 32 + (c & 31)) * 2; }
__device__ __forceinline__ int v_rd_base(int lane) { return ((lane & 3) << 3) | (((lane >> 2) & 3) << 6) | (((lane >> 4) & 1) << 5) | (((lane >> 5) & 1) << 8); }
constexpr int v_rd_off(int d0, int ks, int half) { return d0 * 512 + ks * 4096 + half * 2048; }
template <int OFF> __device__ __forceinline__ s16x4 tr_read(int vb) {
  s16x4 r; asm volatile("ds_read_b64_tr_b16 %0, %1 offset:%2" : "=&v"(r) : "v"(vb), "i"(OFF) : "memory"); return r;
}
template <int D0> __device__ __forceinline__ void pv_one(f32x16& od, int vb, bf16x8 pa0, bf16x8 pa1, bf16x8 pa2, bf16x8 pa3) {
  const s16x4 l0 = tr_read<v_rd_off(D0, 0, 0)>(vb), h0 = tr_read<v_rd_off(D0, 0, 1)>(vb), l1 = tr_read<v_rd_off(D0, 1, 0)>(vb), h1 = tr_read<v_rd_off(D0, 1, 1)>(vb);
  const s16x4 l2 = tr_read<v_rd_off(D0, 2, 0)>(vb), h2 = tr_read<v_rd_off(D0, 2, 1)>(vb), l3 = tr_read<v_rd_off(D0, 3, 0)>(vb), h3 = tr_read<v_rd_off(D0, 3, 1)>(vb);
  asm volatile("s_waitcnt lgkmcnt(0)" ::: "memory"); SBAR();
#define PK(L, H) (bf16x8){L[0], L[1], L[2], L[3], H[0], H[1], H[2], H[3]}
  od = __builtin_amdgcn_mfma_f32_32x32x16_bf16(pa0, PK(l0, h0), od, 0, 0, 0);
  od = __builtin_amdgcn_mfma_f32_32x32x16_bf16(pa1, PK(l1, h1), od, 0, 0, 0);
  od = __builtin_amdgcn_mfma_f32_32x32x16_bf16(pa2, PK(l2, h2), od, 0, 0, 0);
  od = __builtin_amdgcn_mfma_f32_32x32x16_bf16(pa3, PK(l3, h3), od, 0, 0, 0);
#undef PK
}
__device__ __forceinline__ void pv_d0(f32x16* o, int vb, bf16x8 pa0, bf16x8 pa1, bf16x8 pa2, bf16x8 pa3) {
  pv_one<0>(o[0], vb, pa0, pa1, pa2, pa3); pv_one<1>(o[1], vb, pa0, pa1, pa2, pa3); pv_one<2>(o[2], vb, pa0, pa1, pa2, pa3); pv_one<3>(o[3], vb, pa0, pa1, pa2, pa3);
}

__device__ __forceinline__ void attn_unit(unsigned char* wsb, const float* subln_g, int h, int qb, LAS unsigned char* lds, float lam) {
  const int tid = threadIdx.x, wid = __builtin_amdgcn_readfirstlane(tid >> 6), lane = tid & 63, r32 = lane & 31, hi = lane >> 5, sub = wid >> 2, qw = wid & 3;
  LAS unsigned char* V_lds = lds; LAS unsigned char* K_lds = lds + 2 * SHM_V;
  LAS float* wsf = (LAS float*)(lds + 2 * SHM_V + 2 * SHM_K) + wid * 64; LAS float* li_l = wsf; LAS float* al_l = wsf + 32;
  const bf16_t* Kh = (const bf16_t*)(wsb + WS_K) + h * 128; const bf16_t* Vh = (const bf16_t*)(wsb + WS_V) + h * 128;
  const int q0 = qb * 128;
  float m_reg = -1e30f, l_reg = 0; f32x16 o[4] = {}; bf16x8 qr[4];
  const bf16_t* Qw = (const bf16_t*)(wsb + WS_Q) + (size_t)(q0 + qw * 32 + r32) * AW + (2 * h + sub) * 64 + hi * 8;
#pragma unroll
  for (int d0 = 0; d0 < 4; ++d0) qr[d0] = *(const bf16x8*)(Qw + d0 * 16);
  const int sr = tid >> 4, sc = (tid & 15) * 8, vst0 = v_st(sr, sc), vst1 = v_st(32 + sr, sc);
  const int vb0 = (int)(size_t)V_lds + v_rd_base(lane);
  struct { bf16x8 vs0, vs1, ks0, ks1; } sr_[2];
#define SLOAD(i, k0) do { sr_[i].vs0 = *(const bf16x8*)(&Vh[(long)((k0) + sr) * LDK + sc]); sr_[i].vs1 = *(const bf16x8*)(&Vh[(long)((k0) + 32 + sr) * LDK + sc]); \
    sr_[i].ks0 = *(const bf16x8*)(&Kh[(long)((k0) + sr) * LDK + sc]); sr_[i].ks1 = *(const bf16x8*)(&Kh[(long)((k0) + 32 + sr) * LDK + sc]); } while (0)
#define SWRITE(b, i) do { *(LAS bf16x8*)(V_lds + (b) * SHM_V + vst0) = sr_[i].vs0; *(LAS bf16x8*)(V_lds + (b) * SHM_V + vst1) = sr_[i].vs1; const int kc = sc * 2; \
    *(LAS bf16x8*)(K_lds + (b) * SHM_K + KSWZ(sr, kc)) = sr_[i].ks0; *(LAS bf16x8*)(K_lds + (b) * SHM_K + KSWZ(32 + sr, kc)) = sr_[i].ks1; } while (0)
#define SWAIT() asm volatile("s_waitcnt vmcnt(4)" ::: "memory")
#define RESC(a) do { if (__any((a) < 1.f)) { if (hi == 0) al_l[r32] = (a); asm volatile("s_waitcnt lgkmcnt(0)" ::: "memory"); \
    _Pragma("unroll") for (int d = 0; d < 4; ++d) _Pragma("unroll") for (int r = 0; r < 16; ++r) o[d][r] *= al_l[crow(r, hi)]; } } while (0)
  f32x16 pA0, pA1, pB0, pB1; float mnA, mnB, alA, alB; bf16x8 pa0, pa1, pa2, pa3; constexpr int NT = NKV / KVBLK;
  constexpr int SE = 0, SO = 1;
  SLOAD(SE, 0); asm volatile("s_waitcnt vmcnt(0)" ::: "memory"); SWRITE(0, SE); __syncthreads();
  qkt(pA0, pA1, K_lds, qr, r32, hi, sub); partialSM(pA0, pA1, m_reg, mnA, alA);
  SLOAD(SO, KVBLK); SLOAD(SE, 2 * KVBLK);
  SWAIT(); SWRITE(1, SO); __syncthreads();
  for (int j = 1; j + 1 < NT; j += 2) {
    SBAR(); qkt(pB0, pB1, K_lds + SHM_K, qr, r32, hi, sub);
    finishSM(pA0, pA1, alA, l_reg, pa0, pa1, pa2, pa3); SBAR();
    SLOAD(SO, (j + 2) * KVBLK); SBAR();
    pv_d0(o, vb0, pa0, pa1, pa2, pa3); partialSM(pB0, pB1, m_reg, mnB, alB);
    __syncthreads(); SWAIT(); SWRITE(0, SE);
    RESC(alB); __syncthreads();
    SBAR(); qkt(pA0, pA1, K_lds, qr, r32, hi, sub);
    finishSM(pB0, pB1, alB, l_reg, pa0, pa1, pa2, pa3); SBAR();
    if (j + 3 < NT) SLOAD(SE, (j + 3) * KVBLK); SBAR();
    pv_d0(o, vb0 + SHM_V, pa0, pa1, pa2, pa3); partialSM(pA0, pA1, m_reg, mnA, alA);
    __syncthreads(); SWAIT(); SWRITE(1, SO);
    RESC(alA); __syncthreads();
  }
  SBAR(); qkt(pB0, pB1, K_lds + SHM_K, qr, r32, hi, sub);
  finishSM(pA0, pA1, alA, l_reg, pa0, pa1, pa2, pa3); SBAR();
  pv_d0(o, vb0, pa0, pa1, pa2, pa3); partialSM(pB0, pB1, m_reg, mnB, alB);
  __syncthreads(); RESC(alB);
  finishSM(pB0, pB1, alB, l_reg, pa0, pa1, pa2, pa3); SBAR();
  pv_d0(o, vb0 + SHM_V, pa0, pa1, pa2, pa3);
  if (hi == 0) li_l[r32] = l_reg; asm volatile("s_waitcnt lgkmcnt(0)" ::: "memory");
  float rli[16];
#pragma unroll
  for (int r = 0; r < 16; ++r) rli[r] = 1.0f / li_l[crow(r, hi)];
  __syncthreads();
  LAS float* xch = (LAS float*)lds + qw * 4096;
  if (sub == 1) {
#pragma unroll
    for (int d0 = 0; d0 < 4; ++d0)
#pragma unroll
      for (int r = 0; r < 16; ++r) xch[(d0 * 16 + r) * 64 + lane] = o[d0][r] * rli[r];
  }
  __syncthreads();
  if (sub == 0) {
    float ssq[16];
#pragma unroll
    for (int r = 0; r < 16; ++r) { float s = 0.f;
#pragma unroll
      for (int d0 = 0; d0 < 4; ++d0) { const float dv = o[d0][r] * rli[r] - lam * xch[(d0 * 16 + r) * 64 + lane]; o[d0][r] = dv; s += dv * dv; }
      ssq[r] = s; }
#pragma unroll
    for (int r = 0; r < 16; ++r) {
#pragma unroll
      for (int off = 1; off < 32; off <<= 1) ssq[r] += __shfl_xor(ssq[r], off);
      ssq[r] = (1.f - LAM_INIT) / sqrtf(ssq[r] * (1.f / 128.f) + EPS); }
    float gg[4];
#pragma unroll
    for (int d0 = 0; d0 < 4; ++d0) gg[d0] = subln_g[d0 * 32 + r32];
    asm volatile("s_waitcnt lgkmcnt(0)" ::: "memory");
#pragma unroll
    for (int r = 0; r < 16; ++r)
#pragma unroll
      for (int d0 = 0; d0 < 4; ++d0) xch[crow(r, hi) * 128 + d0 * 32 + r32] = o[d0][r] * ssq[r] * gg[d0];
    asm volatile("s_waitcnt lgkmcnt(0)" ::: "memory");
    bf16_t* Ow = (bf16_t*)(wsb + WS_AX) + (size_t)(q0 + qw * 32) * AW + h * 128;
#pragma unroll
    for (int it = 0; it < 8; ++it) { const int row = it * 4 + (lane >> 4), ch = lane & 15;
      const f32x4 a = *(const LAS f32x4*)(xch + row * 128 + ch * 8), b = *(const LAS f32x4*)(xch + row * 128 + ch * 8 + 4);
      u32x4 w; w.x = pk2(a.x, a.y); w.y = pk2(a.z, a.w); w.z = pk2(b.x, b.y); w.w = pk2(b.z, b.w);
      *(u32x4*)(Ow + (size_t)row * AW + ch * 8) = w; }
  }
  __syncthreads();
#undef SLOAD
#undef SWRITE
#undef SWAIT
#undef RESC
}
#undef KSWZ
#undef SBAR
}

__device__ __forceinline__ void sgu_unit(const Ctx& C, int chunk, int g, LAS unsigned char* lds) {
    LAS float* vn = (LAS float*)lds; LAS float* stats = (LAS float*)(lds + 65536);
    const int tid = threadIdx.x, lane = tid & 63, w = __builtin_amdgcn_readfirstlane(tid >> 6);
    const bf16_t* VS = (const bf16_t*)(C.ws + WS_VS); const bf16_t* U = (const bf16_t*)(C.ws + WS_U); bf16_t* SX = (bf16_t*)(C.ws + WS_SX);
    for (int t = 0; t < 16; ++t) {
        const int tok = w * 16 + t; const bf16_t* vr = VS + (size_t)(chunk * 128 + tok) * SW; f32x4 v[4]; float s = 0.f;
#pragma unroll
        for (int j = 0; j < 4; ++j) { v[j] = ld_bf16x4(vr + (lane + 64 * j) * 4); s += (v[j].x + v[j].y) + (v[j].z + v[j].w); }
        const float mean = wave_sum(s) * (1.f / SW); float q = 0.f;
#pragma unroll
        for (int j = 0; j < 4; ++j) { const f32x4 d = v[j] - mean; q += (d.x * d.x + d.y * d.y) + (d.z * d.z + d.w * d.w); }
        const float rstd = 1.f / sqrtf(wave_sum(q) * (1.f / SW) + EPS);
        if (lane == 0) { stats[2 * tok] = mean; stats[2 * tok + 1] = rstd; }
    }
    __syncthreads();
#pragma unroll
    for (int k = 0; k < 4; ++k) { const int e8 = tid + 512 * k, j = e8 >> 4, c8 = (e8 & 15) * 8;
        const bf16_t* src = VS + (size_t)(chunk * 128 + j) * SW + g * 128 + c8; const float mean = stats[2 * j], rstd = stats[2 * j + 1];
        const f32x4 a = ld_bf16x4(src), b = ld_bf16x4(src + 4);
        const f32x4 ga = *(const f32x4*)(C.sgu_ln_g + g * 128 + c8), gb = *(const f32x4*)(C.sgu_ln_g + g * 128 + c8 + 4), ba = *(const f32x4*)(C.sgu_ln_b + g * 128 + c8), bb = *(const f32x4*)(C.sgu_ln_b + g * 128 + c8 + 4);
        *(LAS f32x4*)(vn + j * 128 + c8) = (a - mean) * rstd * ga + ba; *(LAS f32x4*)(vn + j * 128 + c8 + 4) = (b - mean) * rstd * gb + bb; }
    __syncthreads();
    for (int ib = 0; ib < 4; ++ib) {
        const int i0 = w * 16 + ib * 4; const float* wr = C.w_spatial + ((size_t)g * 128 + i0) * 128;
        f32x2 acc[4] = {{0.f, 0.f}, {0.f, 0.f}, {0.f, 0.f}, {0.f, 0.f}};
#pragma unroll 8
        for (int j = 0; j < 128; ++j) { const f32x2 v2 = *(const LAS f32x2*)(vn + j * 128 + 2 * lane);
#pragma unroll
            for (int r = 0; r < 4; ++r) acc[r] += v2 * wr[r * 128 + j]; }
#pragma unroll
        for (int r = 0; r < 4; ++r) { const int i = i0 + r; const float bs = C.b_spatial[g * 128 + i]; const size_t oi = (size_t)(chunk * 128 + i) * SW + g * 128 + 2 * lane;
            const unsigned uu = *(const unsigned*)(U + oi);
            *(unsigned*)(SX + oi) = pk2(__uint_as_float(uu << 16) * (acc[r].x + bs), __uint_as_float(uu & 0xffff0000u) * (acc[r].y + bs)); }
    }
    __syncthreads();
}

#define XB_TMO      128
#define XB_XCNT(j)  (256  + 64 * (j))
#define XB_XSUB(j)  (1280 + 64 * (j))
#define XB_XGEN(j)  (2304 + 64 * (j))
#define XB_TOP      3328
#define XB_TOPGEN   3392
#define XCD_BAR_WORDS 3456
#define XB_SPIN_CAP (1u << 22)
__device__ __forceinline__ unsigned xb_ld(unsigned* p)              { return __hip_atomic_load(p, __ATOMIC_RELAXED, __HIP_MEMORY_SCOPE_AGENT); }
__device__ __forceinline__ unsigned xb_add(unsigned* p, unsigned v) { return __hip_atomic_fetch_add(p, v, __ATOMIC_RELAXED, __HIP_MEMORY_SCOPE_AGENT); }
__device__ __forceinline__ unsigned xb_xcc_id() { return (unsigned)__builtin_amdgcn_s_getreg((3 << 11) | 20) & 0xFu; }
#define XB_SPIN(cond, bar) do { unsigned _sp = 0; while (cond) { __builtin_amdgcn_s_sleep(1); \
    if ((++_sp & 255u) == 0u) { if (xb_ld(&(bar)[XB_TMO])) break; if (_sp > XB_SPIN_CAP) { atomicAdd(&(bar)[XB_TMO], 1u); break; } } } } while (0)
struct XcdBarrier { unsigned* bar; unsigned x; volatile LAS unsigned* st; };
__device__ __forceinline__ XcdBarrier xcd_barrier_post(unsigned* bar, volatile LAS unsigned* st) {
    XcdBarrier b; b.bar = bar; b.x = xb_xcc_id(); b.st = st;
    if (threadIdx.x == 0) (void)xb_add(&bar[XB_XCNT(b.x)], 1u);
    return b;
}
__device__ __forceinline__ void xcd_barrier_complete(unsigned* bar, unsigned x, unsigned& nloc, unsigned& nx) {
    const unsigned G = gridDim.x * gridDim.y * gridDim.z;
    unsigned sum, cnt, mine, sp = 0u;
    for (;;) {
        sum = 0u; cnt = 0u; mine = 0u;
#pragma unroll
        for (unsigned j = 0; j < 16; ++j) { const unsigned c = xb_ld(&bar[XB_XCNT(j)]); sum += c; cnt += (c > 0u) ? 1u : 0u; mine = (j == x) ? c : mine; }
        if (sum == G) break;
        __builtin_amdgcn_s_sleep(1);
        if ((++sp & 255u) == 0u) { if (xb_ld(&bar[XB_TMO])) break; if (sp > XB_SPIN_CAP) { atomicAdd(&bar[XB_TMO], 1u); break; } }
    }
    nloc = mine > 0u ? mine : 1u; nx = cnt > 0u ? cnt : 1u;
}
__device__ __forceinline__ void xcd_barrier(const XcdBarrier& b) {
    asm volatile("s_waitcnt vmcnt(0)" ::: "memory");
    __syncthreads();
    if (threadIdx.x == 0) {
        unsigned* bar = b.bar;
        __builtin_amdgcn_s_waitcnt(0);
        unsigned nloc = b.st[0], nx = b.st[1];
        if (nloc == 0u) { xcd_barrier_complete(bar, b.x, nloc, nx); b.st[0] = nloc; b.st[1] = nx; }
        const unsigned old = xb_add(&bar[XB_XSUB(b.x)], 1u);
        const unsigned gen = old / nloc;
        if (old + 1u == (gen + 1u) * nloc) {
            __builtin_amdgcn_fence(__ATOMIC_RELEASE, "agent");
            asm volatile("s_waitcnt vmcnt(0)" ::: "memory");
            const unsigned og = xb_add(&bar[XB_TOP], 1u);
            const unsigned tg = og / nx;
            if (og + 1u == (tg + 1u) * nx) xb_add(&bar[XB_TOPGEN], 1u);
            else XB_SPIN(xb_ld(&bar[XB_TOPGEN]) == tg, bar);
            __builtin_amdgcn_fence(__ATOMIC_ACQUIRE, "agent");
            xb_add(&bar[XB_XGEN(b.x)], 1u);
            asm volatile("s_waitcnt vmcnt(0)" ::: "memory");
        } else {
            XB_SPIN(xb_ld(&bar[XB_XGEN(b.x)]) == gen, bar);
            __builtin_amdgcn_fence(__ATOMIC_ACQUIRE, "agent");
            asm volatile("s_waitcnt vmcnt(0)" ::: "memory");
        }
    }
    __syncthreads();
}

constexpr int LDS_BYTES = 147456, MISC_OFF = 131072 + 320;
constexpr int NPHASE = 10;
__global__ __launch_bounds__(512, 2) void k_mega(Ctx C, int ph_lo, int ph_hi) {
    extern __shared__ __attribute__((aligned(16))) unsigned char lds_raw[];
    LAS unsigned char* lds = (LAS unsigned char*)lds_raw;
    const int tid = threadIdx.x;
    unsigned char* ws = C.ws;
    for (int u = tid; u < (LDS_BYTES - 131072) / 4; u += 512) ((LAS unsigned*)(lds + 131072))[u] = 0u;
    __syncthreads();
    XcdBarrier bar; bar.bar = (unsigned*)(ws + WS_CTL); bar.x = 0; bar.st = nullptr;
    if (ph_hi - ph_lo > 1) bar = xcd_barrier_post((unsigned*)(ws + WS_CTL), (volatile LAS unsigned*)(lds + MISC_OFF));
    const int G = gridDim.x, bx = blockIdx.x;
#define IN(k) (ph_lo <= (k) && (k) < ph_hi)
#define SEAM(k) do { if (IN(k) && IN((k) + 1)) xcd_barrier(bar); } while (0)
#ifndef REP_PHASE
#define REP_PHASE -1
#endif
#define RUNP(k, ...) do { if (IN(k)) { __VA_ARGS__; if (REP_PHASE == (k)) { xcd_barrier(bar); __VA_ARGS__; } } SEAM(k); } while (0)
    RUNP(0, phase0(C, lds));
    RUNP(1, phase1(C));
    RUNP(2, { pg8::ProjSched S{G, bx, (const char*)(ws + WS_AALL), (const char*)(ws + WS_WIG), (size_t)256 * DM * 2};
        pg8::gemm_phase(lds, DM, S, EpiProj{ws, C.b_gate}); phase2_tail(C, lds); });
    RUNP(3, { const float lam = *(const float*)(ws + WS_LAM);
        for (int ui = bx; ui < NH * (SEQ / 128); ui += G) fa::attn_unit(ws, C.subln_g, ui & 7, ui >> 3, lds, lam);
        for (int si = bx; si < (SEQ / CHUNK) * NGRP; si += G) sgu_unit(C, si >> 3, si & 7, lds); });
    RUNP(4, { pg8::GridSched S{SEQ / 256, DM / 256, 2, G, bx, (const char*)(ws + WS_AX), (const char*)(ws + WS_SX), (const char*)(ws + WS_WBA), (const char*)(ws + WS_WBS), (size_t)256 * AW * 2};
        pg8::gemm_phase(lds, AW, S, EpiMerge{ws}); });
    RUNP(5, { pg8::GridSched S{SEQ / 256, DM / 256, 1, G, bx, (const char*)(ws + WS_T), nullptr, (const char*)(ws + WS_WOUT), nullptr, (size_t)256 * DM * 2};
        pg8::gemm_phase(lds, DM, S, EpiOut{ws, C.x}); });
    RUNP(6, phase_h2(C));
    RUNP(7, { pg8::GridSched S{SEQ / 256, FFD / 256, 1, G, bx, (const char*)(ws + WS_H2), nullptr, (const char*)(ws + WS_WFF1), nullptr, (size_t)256 * DM * 2};
        pg8::gemm_phase(lds, DM, S, EpiFF1{ws}); });
    RUNP(8, { pg8::GridSched S{SEQ / 256, DM / 256, 1, G, bx, (const char*)(ws + WS_F), nullptr, (const char*)(ws + WS_WFF2), nullptr, (size_t)256 * FFD * 2};
        pg8::gemm_phase(lds, FFD, S, EpiFF2{ws, C.out}); });
    if (IN(9)) { phase_final(C); }
#undef RUNP
#undef IN
#undef SEAM
}

extern "C" void kernel_launch(void* const* d_in, const int* in_sizes, int n_in, void* d_out, int out_size, void* d_ws, size_t ws_size, hipStream_t stream) {
    static int grid = 0;
    if (grid == 0) {
        if (n_in != 26 || in_sizes[0] != SEQ * DM || out_size != SEQ * DM || ws_size < WS_END) {
            fprintf(stderr, "kernel_launch: unexpected shapes n_in %d in0 %d out %d ws %zu (need %zu)\n", n_in, n_in > 0 ? in_sizes[0] : -1, out_size, ws_size, (size_t)WS_END); grid = -1; return; }
        if (hipFuncSetAttribute((const void*)k_mega, hipFuncAttributeMaxDynamicSharedMemorySize, LDS_BYTES) != hipSuccess) { fprintf(stderr, "hipFuncSetAttribute k_mega failed\n"); grid = -1; return; }
        int dev = 0, cus = 0, per_cu = 0;
        if (hipGetDevice(&dev) != hipSuccess || hipDeviceGetAttribute(&cus, hipDeviceAttributeMultiprocessorCount, dev) != hipSuccess) { fprintf(stderr, "device query failed\n"); grid = -1; return; }
        if (hipOccupancyMaxActiveBlocksPerMultiprocessor(&per_cu, (const void*)k_mega, 512, LDS_BYTES) != hipSuccess || per_cu < 1) { fprintf(stderr, "occupancy query failed (%d)\n", per_cu); (void)hipGetLastError(); grid = -1; return; }
        grid = cus * per_cu;
        fprintf(stderr, "kernel_launch: %d CUs x %d workgroups\n", cus, per_cu);
    }
    if (grid < 0) return;
    Ctx C{};
    const float** f = (const float**)&C;
    for (int i = 0; i < 26; ++i) f[i] = (const float*)d_in[i];
    C.out = (float*)d_out; C.ws = (unsigned char*)d_ws;
    (void)hipMemsetAsync((char*)d_ws + WS_CTL, 0, 64 * KiB, stream);
    int lo = 0, hi = NPHASE;
    void* args[] = {(void*)&C, (void*)&lo, (void*)&hi};
    const hipError_t e = hipLaunchCooperativeKernel((const void*)k_mega, dim3(grid), dim3(512), args, LDS_BYTES, stream);
    if (e != hipSuccess) fprintf(stderr, "kernel_launch: cooperative launch failed: %s (grid %d)\n", hipGetErrorString(e), grid);
}
```
